# Optimizing an MI355X kernel written in HIP

```python
import math
import jax, jax.numpy as jnp
from jax import lax
import numpy as np

D_MODEL = 1024
BATCH = 4
SEQ = 4096
DEPTH = 2
DEC_BATCH = 32
DEC_SEQ = 4
PAST_LEN = 16384
PAGE_SIZE = 128

N_HEADS_A = 8
HEAD_DIM_A = 64
D_A = N_HEADS_A * HEAD_DIM_A
ROT_DIM = HEAD_DIM_A // 4
ROPE_THETA = 500000.0
DILATED_PATTERNS = ((128, 1), (512, 4), (2048, 16))
MAX_WINDOW = 2048
ATTN_BLOCK = 32
N_HEADS_B = 4
DV_B = D_MODEL // 2
DK_B = DV_B // 2
DV_HEAD = DV_B // N_HEADS_B
DK_HEAD = DK_B // N_HEADS_B
GATE_RANK = 16
GATE_TAU = 16.0
GLA_CHUNK = 64
D_MIX = D_A + DV_B
SPLITS = (D_A, 2 * D_A, 3 * D_A, 3 * D_A + DK_B, 3 * D_A + 2 * DK_B,
          3 * D_A + 2 * DK_B + DV_B, 3 * D_A + 2 * DK_B + 2 * DV_B)
IN_COLS = 3 * D_A + 2 * DK_B + 2 * DV_B + GATE_RANK
D_FF = 2816
CONV_W = 3
EPS = 1e-6

kernel_name = "hymba_longnet_gla_convffn_step"


def rms_norm(x, g):
    xf = x.astype(jnp.float32)
    y = xf * lax.rsqrt(jnp.mean(xf * xf, axis=-1, keepdims=True) + EPS)
    return (y * g.astype(jnp.float32)).astype(x.dtype)


def partial_rope(x, pos):
    half = ROT_DIM // 2
    inv_freq = ROPE_THETA ** (-jnp.arange(half, dtype=jnp.float32) / half)
    ang = pos.astype(jnp.float32)[:, None] * inv_freq[None, :]
    cos = jnp.cos(ang)[None, :, None, :]
    sin = jnp.sin(ang)[None, :, None, :]
    x1 = x[..., :half].astype(jnp.float32)
    x2 = x[..., half:ROT_DIM].astype(jnp.float32)
    rot = jnp.concatenate([x1 * cos - x2 * sin, x2 * cos + x1 * sin], axis=-1).astype(x.dtype)
    return jnp.concatenate([rot, x[..., ROT_DIM:]], axis=-1)


def dilated_window_attention(q, k_all, v_all, offset):
    B, T, H, hd = q.shape
    blk = math.gcd(T, ATTN_BLOCK)
    nblk = T // blk
    scale = hd ** -0.5
    q_blocks = q.reshape(B, nblk, blk, H, hd).swapaxes(0, 1)

    def one_block(args):
        q_blk, b = args
        rows = offset + b * blk + jnp.arange(blk, dtype=jnp.int32)
        outs, lses = [], []
        for window, dil in DILATED_PATTERNS:
            idx = rows[:, None] - dil * jnp.arange(window // dil + 1, dtype=jnp.int32)[None, :]
            valid = idx >= 0
            idx = jnp.maximum(idx, 0)
            k_g = k_all[:, idx]
            v_g = v_all[:, idx]
            s = jnp.einsum('bqhd,bqnhd->bhqn', q_blk, k_g,
                           preferred_element_type=jnp.float32) * scale
            s = jnp.where(valid[None, None], s, -jnp.inf)
            lse = jax.nn.logsumexp(s, axis=-1)
            p = jnp.exp(s - lse[..., None])
            outs.append(jnp.einsum('bhqn,bqnhd->bqhd', p, v_g.astype(jnp.float32)))
            lses.append(lse)
        w = jax.nn.softmax(jnp.stack(lses), axis=0)
        w = w.transpose(0, 1, 3, 2)[..., None]
        return jnp.sum(w * jnp.stack(outs), axis=0).astype(q.dtype)

    out = lax.map(one_block, (q_blocks, jnp.arange(nblk, dtype=jnp.int32)))
    return out.swapaxes(0, 1).reshape(B, T, H, hd)


def gla_chunked(q, k, v, log_a, s0):
    B, T, H, dk = q.shape
    dv = v.shape[-1]
    c = math.gcd(T, GLA_CHUNK)
    n = T // c

    def to_chunks(x):
        return x.reshape(B, n, c, H, x.shape[-1]).transpose(1, 0, 3, 2, 4)

    causal = jnp.tril(jnp.ones((c, c), dtype=bool))[None, None, :, :, None]

    def step(S, inp):
        qi, ki, vi, ai = inp
        qf = qi.astype(jnp.float32)
        kf = ki.astype(jnp.float32)
        vf = vi.astype(jnp.float32)
        b = jnp.cumsum(ai.astype(jnp.float32), axis=2)
        diff = b[:, :, :, None, :] - b[:, :, None, :, :]
        decay = jnp.exp(jnp.where(causal, diff, -jnp.inf))
        attn = jnp.einsum('bhtk,bhsk,bhtsk->bhts', qf, kf, decay)
        o = (jnp.einsum('bhts,bhsv->bhtv', attn, vf)
             + jnp.einsum('bhtk,bhkv->bhtv', qf * jnp.exp(b), S))
        b_last = b[:, :, -1:, :]
        S_new = (jnp.exp(b_last[:, :, 0, :])[..., None] * S
                 + jnp.einsum('bhsk,bhsv->bhkv', kf * jnp.exp(b_last - b), vf))
        return S_new, o

    S_fin, o = lax.scan(step, s0.astype(jnp.float32),
                        (to_chunks(q), to_chunks(k), to_chunks(v), to_chunks(log_a)))
    o = o.transpose(1, 0, 3, 2, 4).reshape(B, T, H, dv)
    return o.astype(v.dtype), S_fin.astype(v.dtype)


def token_mixers(h, pos, k_buf, v_buf, s0, w_in, w_gate2, b_gate, g_gla, w_out):
    B, T, _ = h.shape
    proj = h @ w_in
    q_a, k_a, v_a, q_b, k_b, v_b, r_b, gate_lr = jnp.split(proj, SPLITS, axis=-1)
    q_a = partial_rope(q_a.reshape(B, T, N_HEADS_A, HEAD_DIM_A), pos)
    k_a = partial_rope(k_a.reshape(B, T, N_HEADS_A, HEAD_DIM_A), pos)
    v_a = v_a.reshape(B, T, N_HEADS_A, HEAD_DIM_A)
    k_all = jnp.concatenate([k_buf, k_a], axis=1)
    v_all = jnp.concatenate([v_buf, v_a], axis=1)
    o_a = dilated_window_attention(q_a, k_all, v_all, k_buf.shape[1]).reshape(B, T, D_A)
    log_a = jax.nn.log_sigmoid((gate_lr @ w_gate2 + b_gate).astype(jnp.float32)) / GATE_TAU
    q_b = q_b.reshape(B, T, N_HEADS_B, DK_HEAD) * (DK_HEAD ** -0.5)
    k_b = k_b.reshape(B, T, N_HEADS_B, DK_HEAD)
    v_b = v_b.reshape(B, T, N_HEADS_B, DV_HEAD)
    o_b, s_new = gla_chunked(q_b, k_b, v_b, log_a.reshape(B, T, N_HEADS_B, DK_HEAD), s0)
    o_b = rms_norm(o_b, g_gla) * jax.nn.silu(r_b.reshape(B, T, N_HEADS_B, DV_HEAD))
    o = jnp.concatenate([o_a, o_b.reshape(B, T, DV_B)], axis=-1)
    return o @ w_out, k_a, v_a, s_new


def conv_ffn(h, conv_buf, w_up, conv_w, conv_b, w_down):
    T = h.shape[1]
    u = h @ w_up
    ext = jnp.concatenate([conv_buf, u], axis=1)
    c = conv_b + conv_w[0] * ext[:, 0:T]
    for i in range(1, CONV_W):
        c = c + conv_w[i] * ext[:, i:i + T]
    gate, up = jnp.split(c, 2, axis=-1)
    y = jax.nn.gelu(gate, approximate=True) * up
    return y @ w_down, ext[:, T:]


def run_trunk(x, pos, k_bufs, v_bufs, gla_states, conv_bufs, params):
    (g_mix_pre, g_mix_post, g_ffn_pre, g_ffn_post, w_in, w_gate2, b_gate, g_gla, w_out,
     w_up, conv_w, conv_b, w_down) = params
    new_k, new_v, new_s, new_c = [], [], [], []
    for l in range(DEPTH):
        h = rms_norm(x, g_mix_pre[l])
        m, k_rows, v_rows, s_l = token_mixers(h, pos, k_bufs[l], v_bufs[l], gla_states[l],
                                              w_in[l], w_gate2[l], b_gate[l], g_gla[l], w_out[l])
        x = x + rms_norm(m, g_mix_post[l])
        h = rms_norm(x, g_ffn_pre[l])
        f, c_l = conv_ffn(h, conv_bufs[l], w_up[l], conv_w[l], conv_b[l], w_down[l])
        x = x + rms_norm(f, g_ffn_post[l])
        new_k.append(k_rows)
        new_v.append(v_rows)
        new_s.append(s_l)
        new_c.append(c_l)
    return x, jnp.stack(new_k), jnp.stack(new_v), jnp.stack(new_s), jnp.stack(new_c)


def setup_inputs(seed: int = 0) -> dict:
    key = jax.random.key(seed)
    ks = jax.random.split(key, 19)
    win_past = min(MAX_WINDOW, PAST_LEN)

    def nrm(k, shape, scale):
        return jax.random.normal(k, shape, jnp.float32) * scale

    return {
        "x_prompt": nrm(ks[0], (BATCH, SEQ, D_MODEL), 1.0),
        "x_sample": nrm(ks[1], (DEC_BATCH, DEC_SEQ, D_MODEL), 1.0),
        "cache_k_win": nrm(ks[2], (DEPTH, DEC_BATCH, win_past, N_HEADS_A, HEAD_DIM_A), 1.0),
        "cache_v_win": nrm(ks[3], (DEPTH, DEC_BATCH, win_past, N_HEADS_A, HEAD_DIM_A), 1.0),
        "state_gla": nrm(ks[4], (DEPTH, DEC_BATCH, N_HEADS_B, DK_HEAD, DV_HEAD), 1.0),
        "state_ffn_conv": nrm(ks[5], (DEPTH, DEC_BATCH, CONV_W - 1, 2 * D_FF), 1.0),
        "g_mix_pre": 1.0 + nrm(ks[6], (DEPTH, D_MODEL), 0.02),
        "g_mix_post": 1.0 + nrm(ks[7], (DEPTH, D_MODEL), 0.02),
        "g_ffn_pre": 1.0 + nrm(ks[8], (DEPTH, D_MODEL), 0.02),
        "g_ffn_post": 1.0 + nrm(ks[9], (DEPTH, D_MODEL), 0.02),
        "w_in": nrm(ks[10], (DEPTH, D_MODEL, IN_COLS), D_MODEL ** -0.5),
        "w_gate2": nrm(ks[11], (DEPTH, GATE_RANK, DK_B), GATE_RANK ** -0.5),
        "b_gate": nrm(ks[12], (DEPTH, DK_B), 0.01),
        "g_gla": 1.0 + nrm(ks[13], (DEPTH, DV_HEAD), 0.02),
        "w_out": nrm(ks[14], (DEPTH, D_MIX, D_MODEL), D_MIX ** -0.5),
        "w_up": nrm(ks[15], (DEPTH, D_MODEL, 2 * D_FF), D_MODEL ** -0.5),
        "conv_w": nrm(ks[16], (DEPTH, CONV_W, 2 * D_FF), CONV_W ** -0.5),
        "conv_b": nrm(ks[17], (DEPTH, 2 * D_FF), 0.01),
        "w_down": nrm(ks[18], (DEPTH, D_FF, D_MODEL), D_FF ** -0.5),
    }


def reference(x_prompt, x_sample, cache_k_win, cache_v_win, state_gla, state_ffn_conv,
              g_mix_pre, g_mix_post, g_ffn_pre, g_ffn_post, w_in, w_gate2, b_gate, g_gla,
              w_out, w_up, conv_w, conv_b, w_down):
    params = (g_mix_pre, g_mix_post, g_ffn_pre, g_ffn_post, w_in, w_gate2, b_gate, g_gla,
              w_out, w_up, conv_w, conv_b, w_down)
    B, T, _ = x_prompt.shape
    dt = x_prompt.dtype
    pos_p = jnp.arange(T, dtype=jnp.int32)
    z_kv = jnp.zeros((DEPTH, B, 0, N_HEADS_A, HEAD_DIM_A), dt)
    z_s = jnp.zeros((DEPTH, B, N_HEADS_B, DK_HEAD, DV_HEAD), dt)
    z_c = jnp.zeros((DEPTH, B, CONV_W - 1, 2 * D_FF), dt)
    y_prompt, k_p, v_p, s_p, c_p = run_trunk(x_prompt, pos_p, z_kv, z_kv, z_s, z_c, params)
    win_p = min(MAX_WINDOW, T)
    new_k_win_prompt = k_p[:, :, T - win_p:]
    new_v_win_prompt = v_p[:, :, T - win_p:]
    pos_s = PAST_LEN + jnp.arange(x_sample.shape[1], dtype=jnp.int32)
    y_sample, k_s, v_s, s_s, c_s = run_trunk(x_sample, pos_s, cache_k_win, cache_v_win,
                                             state_gla, state_ffn_conv, params)
    return (y_prompt, y_sample, new_k_win_prompt, new_v_win_prompt, s_p, c_p, k_s, v_s, s_s, c_s)
```

```cpp
#define MK_N_LAUNCHES 21
#include <hip/hip_runtime.h>
#include <cstdio>
#include <cstdint>
#include <cmath>
namespace pg8 {
#define PG8_LAS __attribute__((address_space(3)))
typedef unsigned short bf16_t;
typedef short bf16x8 __attribute__((ext_vector_type(8)));
typedef float f32x4 __attribute__((ext_vector_type(4)));
typedef unsigned u32x4 __attribute__((ext_vector_type(4)));
constexpr int BM = 256, BK = 64, HALF = 128, HTB = HALF * BK * 2  , STAGE_BYTES = 8 * HTB, NXCD = 8, WGM = 8;

__host__ __device__ __forceinline__ int lds_byte(int r, int c) { const int st = (r >> 4) * 2 + (c >> 5), rr = r & 15, cc = c & 31, ob = rr * 64 + cc * 2; return st * 1024 + (ob ^ (((ob >> 9) & 1) << 5)); }
__host__ __device__ __forceinline__ void stage_rc(int b, int& R, int& C) { const int st = b / 1024, sb = b % 1024, swz = sb ^ (((sb >> 9) & 1) << 5); R = (st >> 1) * 16 + swz / 64; C = (st & 1) * 32 + (swz % 64) / 2; }
__host__ __device__ __forceinline__ int perm32(int rho) { const int n = rho >> 4, i = rho & 15; return 8 * (i >> 2) + 4 * n + (i & 3); }

struct Unit { int pm, pn; };
struct Gemm { const bf16_t* A; const bf16_t* Bt; int M, N, K; };

struct StaticOrder {
    int nM, nN, nwg, G, c;
    __host__ __device__ void init(int M, int N, int G_, int c_) { nM = M / BM; nN = N / BM; nwg = nM * nN; G = G_; c = c_; }
    __host__ __device__ bool next(int i, Unit& u) const {
        const long L = (long)i * G + c; if (L >= nwg) return false;
        int wgid = (int)L; { const int q = nwg / NXCD, r = nwg % NXCD, xcd = wgid % NXCD, off = wgid / NXCD; wgid = (xcd < r ? xcd * (q + 1) : r * (q + 1) + (xcd - r) * q) + off; }
        const int nig = WGM * nN, gid = wgid / nig, fm = gid * WGM, gsz = (nM - fm) < WGM ? (nM - fm) : WGM;
        u.pm = fm + ((wgid % nig) % gsz); u.pn = (wgid % nig) / gsz; return true;
    }
    __device__ __forceinline__ void a_ready(const Unit&) const {}
    __device__ __forceinline__ void done(const Unit&) const {}
};


__device__ __forceinline__ unsigned cvt_pk_bf16(float lo, float hi) { unsigned r; asm volatile("v_cvt_pk_bf16_f32 %0, %1, %2" : "=v"(r) : "v"(lo), "v"(hi)); return r; }


constexpr size_t EP_MiB = 1u << 20;
constexpr size_t EP_CSTAB = 51 * EP_MiB, EP_RINV = 52 * EP_MiB, EP_GL = 53 * EP_MiB, EP_QA = 154 * EP_MiB, EP_KA = 171 * EP_MiB, EP_VA = 188 * EP_MiB, EP_QB = 205 * EP_MiB, EP_KB = 214 * EP_MiB, EP_VB = 223 * EP_MiB, EP_RB = 240 * EP_MiB, EP_U = 440 * EP_MiB;
constexpr size_t EP_O_KP = 16908288, EP_O_VP = 25296896, EP_O_CP = 33947648, EP_O_KS = 34037760, EP_O_VS = 34168832, EP_O_CS = 36397056;
constexpr int ROWS_P = 16384, ROWS_T = 16512;

struct EpiProj {
    static constexpr bool PERM = true, AFTER_DRAIN = false;
    unsigned char* ws; float* out; int l;
    __device__ __forceinline__ void operator()(const f32x4 (&acc)[2][2][4][2], const Unit& u, int wr, int wc, int fr, int fq) const {
        const float* rinv = (const float*)(ws + EP_RINV); const float* cs = (const float*)(ws + EP_CSTAB);
        bf16_t* QA = (bf16_t*)(ws + EP_QA); bf16_t* KA = (bf16_t*)(ws + EP_KA); bf16_t* VA = (bf16_t*)(ws + EP_VA); bf16_t* QB = (bf16_t*)(ws + EP_QB); bf16_t* KB = (bf16_t*)(ws + EP_KB);
        bf16_t* VB = (bf16_t*)(ws + EP_VB); bf16_t* RB = (bf16_t*)(ws + EP_RB); float* GL = (float*)(ws + EP_GL);
        float* okp = out + EP_O_KP + (size_t)l * 4 * 2048 * 512; float* ovp = out + EP_O_VP + (size_t)l * 4 * 2048 * 512; float* oks = out + EP_O_KS + (size_t)l * 128 * 512; float* ovs = out + EP_O_VS + (size_t)l * 128 * 512;
        const int pn = u.pn;
        const bool rope_wave = (pn < 4) && ((wc & 1) == 0);
#pragma unroll
        for (int ai = 0; ai < 2; ++ai)
#pragma unroll
            for (int m = 0; m < 4; ++m) {
                const int row = u.pm * BM + ai * HALF + wr * 64 + m * 16 + fr;
                const float rs = rinv[row];
                const int pidx = row < ROWS_P ? (row & 4095) : (row < ROWS_T ? 4096 + ((row - ROWS_P) & 3) : 0);
                const bool ok = row < ROWS_T;
#pragma unroll
                for (int bj = 0; bj < 2; ++bj) {
                    const int c0 = pn * BM + bj * HALF + wc * 32 + 8 * fq;
                    float v[8];
#pragma unroll
                    for (int j = 0; j < 4; ++j) { v[j] = acc[ai][bj][m][0][j] * rs; v[4 + j] = acc[ai][bj][m][1][j] * rs; }
                    if (rope_wave) {
                        float o[8];
#pragma unroll
                        for (int j = 0; j < 8; ++j) o[j] = __shfl_xor(v[j], 16);
                        if (fq < 2) {
                            const f32x4* cp = (const f32x4*)(cs + (size_t)pidx * 16);
                            const f32x4 c01 = cp[0], c23 = cp[1], c45 = cp[2], c67 = cp[3];
                            const float cc[8] = {c01[0], c01[2], c23[0], c23[2], c45[0], c45[2], c67[0], c67[2]};
                            const float ss[8] = {c01[1], c01[3], c23[1], c23[3], c45[1], c45[3], c67[1], c67[3]};
                            const float sg = fq == 0 ? -1.f : 1.f;
#pragma unroll
                            for (int j = 0; j < 8; ++j) v[j] = v[j] * cc[j] + sg * o[j] * ss[j];
                        }
                    }
                    if (pn < 2 || pn == 6) {
#pragma unroll
                        for (int j = 0; j < 8; ++j) v[j] *= 0.125f;
                    }
                    u32x4 w; w.x = cvt_pk_bf16(v[0], v[1]); w.y = cvt_pk_bf16(v[2], v[3]); w.z = cvt_pk_bf16(v[4], v[5]); w.w = cvt_pk_bf16(v[6], v[7]);
                    if (!ok) continue;
                    if (pn < 2) { *(u32x4*)(QA + (size_t)row * 512 + c0) = w; }
                    else if (pn < 6) {
                        const bool isk = pn < 4; const int c = c0 - (isk ? 512 : 1024);
                        *(u32x4*)((isk ? KA : VA) + (size_t)row * 512 + c) = w;
                        float* op = nullptr;
                        if (row < ROWS_P) { const int t = row & 4095; if (t >= 2048) op = (isk ? okp : ovp) + ((size_t)((row >> 12) * 2048 + (t - 2048))) * 512 + c; }
                        else op = (isk ? oks : ovs) + (size_t)(row - ROWS_P) * 512 + c;
                        if (op) { *(f32x4*)op = (f32x4){v[0], v[1], v[2], v[3]}; *(f32x4*)(op + 4) = (f32x4){v[4], v[5], v[6], v[7]}; }
                    }
                    else if (pn == 6) { *(u32x4*)(QB + (size_t)row * 256 + (c0 - 1536)) = w; }
                    else if (pn == 7) { *(u32x4*)(KB + (size_t)row * 256 + (c0 - 1792)) = w; }
                    else if (pn < 10) { *(u32x4*)(VB + (size_t)row * 512 + (c0 - 2048)) = w; }
                    else if (pn < 12) { *(u32x4*)(RB + (size_t)row * 512 + (c0 - 2560)) = w; }
                    else { const int c = c0 - 3072; if (c < 16) { float* gp = GL + (size_t)row * 16 + c; *(f32x4*)gp = (f32x4){v[0], v[1], v[2], v[3]}; *(f32x4*)(gp + 4) = (f32x4){v[4], v[5], v[6], v[7]}; } }
                }
            }
    }
};

struct EpiF32 {
    static constexpr bool PERM = false, AFTER_DRAIN = false;
    float* O; int ldc;
    __device__ __forceinline__ void operator()(const f32x4 (&acc)[2][2][4][2], const Unit& u, int wr, int wc, int fr, int fq) const {
        const int col0 = u.pn * BM + wc * 32 + 4 * fq;
#pragma unroll
        for (int ai = 0; ai < 2; ++ai)
#pragma unroll
            for (int m = 0; m < 4; ++m) {
                const int row = u.pm * BM + ai * HALF + wr * 64 + m * 16 + fr;
                if (row >= ROWS_T) continue;
                float* rp = O + (size_t)row * ldc + col0;
#pragma unroll
                for (int bj = 0; bj < 2; ++bj)
#pragma unroll
                    for (int n = 0; n < 2; ++n) *(f32x4*)(rp + bj * HALF + n * 16) = acc[ai][bj][m][n];
            }
    }
};

struct EpiUp {
    static constexpr bool PERM = true, AFTER_DRAIN = false;
    unsigned char* ws; float* out; int l;
    __device__ __forceinline__ void operator()(const f32x4 (&acc)[2][2][4][2], const Unit& u, int wr, int wc, int fr, int fq) const {
        const float* rinv = (const float*)(ws + EP_RINV); bf16_t* U = (bf16_t*)(ws + EP_U);
        float* ocp = out + EP_O_CP + (size_t)l * 4 * 2 * 5632; float* ocs = out + EP_O_CS + (size_t)l * 32 * 2 * 5632;
#pragma unroll
        for (int ai = 0; ai < 2; ++ai)
#pragma unroll
            for (int m = 0; m < 4; ++m) {
                const int row = u.pm * BM + ai * HALF + wr * 64 + m * 16 + fr;
                if (row >= ROWS_T) continue;
                const float rs = rinv[row];
                float* op = nullptr;
                if (row < ROWS_P) { const int t = row & 4095; if (t >= 4094) op = ocp + (size_t)((row >> 12) * 2 + (t - 4094)) * 5632; }
                else { const int i = (row - ROWS_P) & 3; if (i >= 2) op = ocs + (size_t)(((row - ROWS_P) >> 2) * 2 + (i - 2)) * 5632; }
#pragma unroll
                for (int bj = 0; bj < 2; ++bj) {
                    const int c0 = u.pn * BM + bj * HALF + wc * 32 + 8 * fq;
                    const f32x4 v0 = acc[ai][bj][m][0] * rs, v1 = acc[ai][bj][m][1] * rs;
                    u32x4 w; w.x = cvt_pk_bf16(v0[0], v0[1]); w.y = cvt_pk_bf16(v0[2], v0[3]); w.z = cvt_pk_bf16(v1[0], v1[1]); w.w = cvt_pk_bf16(v1[2], v1[3]);
                    *(u32x4*)(U + (size_t)row * 5632 + c0) = w;
                    if (op) { *(f32x4*)(op + c0) = v0; *(f32x4*)(op + c0 + 4) = v1; }
                }
            }
    }
};

template <class Epi, class Sched, bool ALIGN_EPI = false, bool SP2 = false>
__device__ __forceinline__ void gemm_phase(PG8_LAS unsigned char* lds, const Gemm g, const Sched& S, const Epi& E) {
    const int tid = threadIdx.x, wid = __builtin_amdgcn_readfirstlane(tid >> 6), lane = tid & 63, wr = wid >> 2, wc = wid & 3, fr = lane & 15, fq = lane >> 4;
    const int K = g.K, nt = K / BK;
    unsigned voffA[2], voffB[2];
#pragma unroll
    for (int i = 0; i < 2; ++i) { int R, C; stage_rc(tid * 16 + i * 8192, R, C); const int Rb = Epi::PERM ? ((R & ~31) + perm32(R & 31)) : R;
        voffA[i] = (unsigned)(R * K + C) * 2u; voffB[i] = (unsigned)(Rb * K + C) * 2u; }
    const size_t kstep = (size_t)(BK * 2);
    const size_t hstep = (size_t)HALF * K * 2;
    const size_t tstep = 2 * hstep;
    const unsigned ldsw = (unsigned)wid * 1024u;
    const int aoff = lds_byte(wr * 64 + fr, fq * 8), boff = lds_byte(wc * 32 + fr, fq * 8);
#define PG8_SA(b, h) (((b) * 2 + (h)) * HTB)
#define PG8_SB(b, h) ((4 + (b) * 2 + (h)) * HTB)
#define PG8_STAGE(bufoff, gbase, voff) do { _Pragma("unroll") for (int _i = 0; _i < 2; ++_i) \
        __builtin_amdgcn_global_load_lds((const unsigned*)((const char*)(gbase) + (voff)[_i]), (PG8_LAS unsigned*)(lds + (bufoff) + ldsw + _i * 8192), 16, 0, 0); } while (0)
#define PG8_LDA(dst, b, h) do { _Pragma("unroll") for (int m = 0; m < 4; ++m) _Pragma("unroll") for (int k = 0; k < 2; ++k) dst[m][k] = *(const PG8_LAS bf16x8*)(lds + PG8_SA(b, h) + aoff + m * 2048 + k * 1024); } while (0)
#define PG8_LDB(dst, b, h) do { _Pragma("unroll") for (int n = 0; n < 2; ++n) _Pragma("unroll") for (int k = 0; k < 2; ++k) dst[n][k] = *(const PG8_LAS bf16x8*)(lds + PG8_SB(b, h) + boff + n * 2048 + k * 1024); } while (0)
#define PG8_MMA(ai, bj, At, Bt) do { __builtin_amdgcn_s_setprio(1); _Pragma("unroll") for (int m = 0; m < 4; ++m) _Pragma("unroll") for (int n = 0; n < 2; ++n) _Pragma("unroll") for (int k = 0; k < 2; ++k) \
        acc[ai][bj][m][n] = __builtin_amdgcn_mfma_f32_16x16x32_bf16(Bt[n][k], At[m][k], acc[ai][bj][m][n], 0, 0, 0); __builtin_amdgcn_s_setprio(0); } while (0)
#define PG8_WAIT_V(n) asm volatile("s_waitcnt vmcnt(" #n ")" ::: "memory")
#define PG8_WAIT_L(n) asm volatile("s_waitcnt lgkmcnt(" #n ")" ::: "memory")
#define PG8_BAR __builtin_amdgcn_s_barrier()
#define PG8_SCHED __builtin_amdgcn_sched_barrier(0)
    Unit cur, nxt; int ui = 0;
    if (!S.next(0, cur)) return;
    f32x4 acc[2][2][4][2];
#pragma unroll
    for (int a = 0; a < 2; ++a)
#pragma unroll
        for (int b = 0; b < 2; ++b)
#pragma unroll
            for (int m = 0; m < 4; ++m)
#pragma unroll
                for (int n = 0; n < 2; ++n) acc[a][b][m][n] = (f32x4){0.f, 0.f, 0.f, 0.f};
    bf16x8 At[4][2], B0[2][2], B1[2][2];
    const char* cA = (const char*)g.A + (size_t)cur.pm * tstep; const char* cB = (const char*)g.Bt + (size_t)cur.pn * tstep;
    S.a_ready(cur);
    if constexpr (SP2) {
        PG8_STAGE(PG8_SB(0, 0), cB, voffB); PG8_STAGE(PG8_SB(0, 1), cB + hstep, voffB); PG8_STAGE(PG8_SA(0, 0), cA, voffA); PG8_STAGE(PG8_SA(0, 1), cA + hstep, voffA);
        if (wr == 1) PG8_BAR;
        PG8_WAIT_V(2); PG8_BAR;
        PG8_STAGE(PG8_SB(1, 0), cB + kstep, voffB); PG8_STAGE(PG8_SA(1, 0), cA + kstep, voffA); PG8_STAGE(PG8_SB(1, 1), cB + hstep + kstep, voffB);
        PG8_WAIT_V(6); PG8_BAR;
    } else {
        PG8_STAGE(PG8_SB(0, 0), cB, voffB); PG8_STAGE(PG8_SA(0, 0), cA, voffA); PG8_STAGE(PG8_SB(0, 1), cB + hstep, voffB); PG8_STAGE(PG8_SA(0, 1), cA + hstep, voffA);
        if (wr == 1) PG8_BAR;
        PG8_WAIT_V(4); PG8_BAR;
        PG8_STAGE(PG8_SB(1, 0), cB + kstep, voffB); PG8_STAGE(PG8_SA(1, 0), cA + kstep, voffA); PG8_STAGE(PG8_SB(1, 1), cB + hstep + kstep, voffB);
        PG8_WAIT_V(6); PG8_BAR;
    }
    for (;;) {
        const bool has_next = S.next(ui + 1, nxt);
        const char* nA = has_next ? (const char*)g.A + (size_t)nxt.pm * tstep : cA; const char* nB = has_next ? (const char*)g.Bt + (size_t)nxt.pn * tstep : cB;
        for (int t = 0; t < nt; t += 2) {
            const bool last = (t == nt - 2);
            const char* a1 = cA + (size_t)(t + 1) * kstep;
            const char* a2 = last ? nA : cA + (size_t)(t + 2) * kstep; const char* b2 = last ? nB : cB + (size_t)(t + 2) * kstep;
            const char* a3 = a2 + kstep; const char* b3 = b2 + kstep;
            if (last && has_next) S.a_ready(nxt);
            if constexpr (SP2) {
            PG8_LDB(B0, 0, 0); PG8_LDB(B1, 0, 1); PG8_SCHED; PG8_LDA(At, 0, 0); PG8_STAGE(PG8_SA(1, 1), a1 + hstep, voffA);
            PG8_WAIT_V(8); PG8_WAIT_L(0); PG8_BAR; PG8_MMA(0, 0, At, B0); PG8_MMA(0, 1, At, B1); PG8_BAR; PG8_SCHED;
            PG8_LDA(At, 0, 1); PG8_STAGE(PG8_SB(0, 0), b2, voffB); PG8_STAGE(PG8_SB(0, 1), b2 + hstep, voffB); PG8_STAGE(PG8_SA(0, 0), a2, voffA);
            PG8_WAIT_V(8); PG8_WAIT_L(0); PG8_BAR; PG8_MMA(1, 0, At, B0); PG8_MMA(1, 1, At, B1); PG8_BAR; PG8_SCHED;
            PG8_LDB(B0, 1, 0); PG8_LDB(B1, 1, 1); PG8_SCHED; PG8_LDA(At, 1, 0); PG8_STAGE(PG8_SA(0, 1), a2 + hstep, voffA);
            PG8_WAIT_V(8); PG8_WAIT_L(0); PG8_BAR; PG8_MMA(0, 0, At, B0); PG8_MMA(0, 1, At, B1); PG8_BAR; PG8_SCHED;
            PG8_LDA(At, 1, 1); PG8_STAGE(PG8_SB(1, 0), b3, voffB); PG8_STAGE(PG8_SB(1, 1), b3 + hstep, voffB); PG8_STAGE(PG8_SA(1, 0), a3, voffA);
            PG8_WAIT_V(8); PG8_WAIT_L(0); PG8_BAR; PG8_MMA(1, 0, At, B0); PG8_MMA(1, 1, At, B1); PG8_BAR; PG8_SCHED;
            } else {
            PG8_LDB(B0, 0, 0); PG8_SCHED; PG8_LDA(At, 0, 0); PG8_STAGE(PG8_SA(1, 1), a1 + hstep, voffA);
            PG8_WAIT_L(8); PG8_BAR; PG8_WAIT_L(0); PG8_MMA(0, 0, At, B0); PG8_BAR; PG8_SCHED;
            PG8_LDB(B1, 0, 1); PG8_STAGE(PG8_SB(0, 0), b2, voffB);
            PG8_BAR; PG8_WAIT_L(0); PG8_MMA(0, 1, At, B1); PG8_BAR;
            PG8_LDA(At, 0, 1); PG8_STAGE(PG8_SA(0, 0), a2, voffA);
            PG8_BAR; PG8_WAIT_L(0); PG8_MMA(1, 0, At, B0); PG8_BAR; PG8_SCHED;
            PG8_STAGE(PG8_SB(0, 1), b2 + hstep, voffB);
            PG8_WAIT_V(6); PG8_BAR; PG8_MMA(1, 1, At, B1); PG8_BAR;
            PG8_LDB(B0, 1, 0); PG8_SCHED; PG8_LDA(At, 1, 0); PG8_STAGE(PG8_SA(0, 1), a2 + hstep, voffA);
            PG8_WAIT_L(8); PG8_BAR; PG8_WAIT_L(0); PG8_MMA(0, 0, At, B0); PG8_BAR; PG8_SCHED;
            PG8_LDB(B1, 1, 1); PG8_STAGE(PG8_SB(1, 0), b3, voffB);
            PG8_BAR; PG8_WAIT_L(0); PG8_MMA(0, 1, At, B1); PG8_BAR;
            PG8_LDA(At, 1, 1); PG8_STAGE(PG8_SA(1, 0), a3, voffA);
            PG8_BAR; PG8_WAIT_L(0); PG8_MMA(1, 0, At, B0); PG8_BAR; PG8_SCHED;
            PG8_STAGE(PG8_SB(1, 1), b3 + hstep, voffB);
            PG8_WAIT_V(6); PG8_BAR; PG8_MMA(1, 1, At, B1); PG8_BAR;
            }
        }
        if constexpr (ALIGN_EPI) { if (wr == 0) PG8_BAR; }
        if constexpr (!Epi::AFTER_DRAIN) { int fr_ = fr, fq_ = fq, wr_ = wr, wc_ = wc; asm volatile("" : "+v"(fr_), "+v"(fq_), "+s"(wr_), "+s"(wc_));
            E(acc, cur, wr_, wc_, fr_, fq_); S.done(cur); }
        if (!has_next) break;
#pragma unroll
        for (int a = 0; a < 2; ++a)
#pragma unroll
            for (int b = 0; b < 2; ++b)
#pragma unroll
                for (int m = 0; m < 4; ++m)
#pragma unroll
                    for (int n = 0; n < 2; ++n) acc[a][b][m][n] = (f32x4){0.f, 0.f, 0.f, 0.f};
        cur = nxt; cA = nA; cB = nB; ++ui;
        if constexpr (ALIGN_EPI) { if (wr == 1) PG8_BAR; }
    }
    PG8_WAIT_V(0);
    if constexpr (!ALIGN_EPI) { if (wr == 0) PG8_BAR; }
    PG8_BAR;
    if constexpr (Epi::AFTER_DRAIN) { E.fused(acc, cur, wr, wc, fr, fq, lds, wid, lane); S.done(cur); }
#undef PG8_SA
#undef PG8_SB
#undef PG8_STAGE
#undef PG8_LDA
#undef PG8_LDB
#undef PG8_MMA
#undef PG8_WAIT_V
#undef PG8_WAIT_L
#undef PG8_BAR
#undef PG8_SCHED
}
}

#ifndef PG8_SP2
#define PG8_SP2 true
#endif
#ifndef PG8_ALIGN
#define PG8_ALIGN true
#endif

constexpr int NWAVES = 8;
constexpr int DM = 1024, MP = 16384, MS = 128, MT = MP + MS, MPAD = 16640;
constexpr int NIN = 3328;
constexpr int DFF = 2816, DFF2 = 5632;
constexpr int NLAYER = 2;
constexpr int GLA_UNITS = 1024 + 128;
constexpr float EPS = 1e-6f;
constexpr size_t O_YP = 0, O_YS = 16777216, O_KP = 16908288, O_VP = 25296896, O_SGP = 33685504, O_CP = 33947648, O_KS = 34037760, O_VS = 34168832, O_SGS = 34299904, O_CS = 36397056, O_END = 37117952;

constexpr size_t MiB = 1u << 20;
constexpr size_t WS_CTL = 0, CTL_ZERO_BYTES = 1 * MiB;
constexpr size_t WS_WIN = 1 * MiB, WS_WOUT = 14 * MiB, WS_WUP = 18 * MiB, WS_WDN = 40 * MiB, WS_CSTAB = 51 * MiB, WS_RINV = 52 * MiB, WS_GL = 53 * MiB, WS_GDEC = 55 * MiB;
constexpr size_t WS_XB = 56 * MiB, WS_XRES = 89 * MiB, WS_QA = 154 * MiB, WS_KA = 171 * MiB, WS_VA = 188 * MiB, WS_QB = 205 * MiB, WS_KB = 214 * MiB, WS_VB = 223 * MiB, WS_RB = 240 * MiB;
constexpr size_t WS_BCUM = 257 * MiB, WS_UST = 274 * MiB, WS_SPREV = 310 * MiB, WS_MIX = 342 * MiB, WS_MBUF = 375 * MiB, WS_U = 440 * MiB, WS_Y = 619 * MiB, WS_END = 709 * MiB;
static_assert(WS_WIN + (size_t)NLAYER * NIN * DM * 2 <= WS_WOUT && WS_WUP + (size_t)NLAYER * DFF2 * DM * 2 <= WS_WDN && WS_WDN + (size_t)NLAYER * DM * DFF * 2 <= WS_CSTAB, "ws map (weights)");
static_assert(WS_XB + (size_t)MPAD * DM * 2 <= WS_XRES && WS_XRES + (size_t)MT * DM * 4 <= WS_QA && WS_QA + (size_t)MT * 512 * 2 <= WS_KA && WS_QB + (size_t)MT * 256 * 2 <= WS_KB, "ws map (acts)");
static_assert(WS_BCUM + (size_t)MT * 256 * 4 <= WS_UST && WS_UST + (size_t)GLA_UNITS * 8192 * 4 <= WS_SPREV && WS_SPREV + (size_t)1024 * 8192 * 4 <= WS_MIX && WS_MIX + (size_t)MPAD * DM * 2 <= WS_MBUF, "ws map (gla)");
static_assert(WS_MBUF + (size_t)MT * DM * 4 <= WS_U && WS_U + (size_t)MPAD * DFF2 * 2 <= WS_Y && WS_Y + (size_t)MPAD * DFF * 2 <= WS_END, "ws map (ffn)");
static_assert(pg8::EP_CSTAB == WS_CSTAB && pg8::EP_RINV == WS_RINV && pg8::EP_GL == WS_GL && pg8::EP_QA == WS_QA && pg8::EP_KA == WS_KA && pg8::EP_VA == WS_VA && pg8::EP_QB == WS_QB && pg8::EP_KB == WS_KB && pg8::EP_VB == WS_VB && pg8::EP_RB == WS_RB && pg8::EP_U == WS_U, "epilogue ws offsets");
static_assert(pg8::EP_O_KP == O_KP && pg8::EP_O_VP == O_VP && pg8::EP_O_CP == O_CP && pg8::EP_O_KS == O_KS && pg8::EP_O_VS == O_VS && pg8::EP_O_CS == O_CS, "epilogue out offsets");
constexpr int CW_BAR = 4096;

constexpr int RING_OFF = 0, RING_BYTES = 131072;
constexpr int LDSCTL_OFF = RING_BYTES, MISC_OFF = LDSCTL_OFF + 320;
constexpr int LDS_BYTES = 147456;
static_assert(MISC_OFF + 128 <= LDS_BYTES, "LDS map");

#define GAS __attribute__((address_space(1)))
#define LAS __attribute__((address_space(3)))
typedef unsigned short bf16;
typedef unsigned v4u __attribute__((ext_vector_type(4)));
typedef float f32x4 __attribute__((ext_vector_type(4)));
typedef GAS unsigned gu32;
#define RLX_AGENT __ATOMIC_RELAXED, __HIP_MEMORY_SCOPE_AGENT
#define LDS_WAIT() asm volatile("s_waitcnt lgkmcnt(0)" ::: "memory")
#define VM_WAIT() asm volatile("s_waitcnt vmcnt(0)" ::: "memory")
__device__ __forceinline__ unsigned f2bf(float f) { unsigned u = __builtin_bit_cast(unsigned, f); return (u + 0x7fffu + ((u >> 16) & 1u)) >> 16; }
__device__ __forceinline__ unsigned pk2(float lo, float hi) { return f2bf(lo) | (f2bf(hi) << 16); }
__device__ __forceinline__ float bf2f(unsigned short b) { return __builtin_bit_cast(float, (unsigned)b << 16); }
__device__ __forceinline__ float bflo(unsigned w) { return __builtin_bit_cast(float, w << 16); }
__device__ __forceinline__ float bfhi(unsigned w) { return __builtin_bit_cast(float, w & 0xffff0000u); }
__device__ __forceinline__ float wave_sum(float v) {
#pragma unroll
    for (int o = 1; o < 64; o <<= 1) v += __shfl_xor(v, o);
    return v;
}
__device__ __forceinline__ float wave_max(float v) {
#pragma unroll
    for (int o = 1; o < 64; o <<= 1) v = fmaxf(v, __shfl_xor(v, o));
    return v;
}
#define XB_TMO      128
#define XB_XCNT(j)  (256  + 64 * (j))
#define XB_XSUB(j)  (1280 + 64 * (j))
#define XB_XGEN(j)  (2304 + 64 * (j))
#define XB_TOP      3328
#define XB_TOPGEN   3392
#define XCD_BAR_WORDS 3456
#define XB_SPIN_CAP (1u << 18)

__device__ __forceinline__ unsigned xb_ld(unsigned* p)              { return __hip_atomic_load(p, __ATOMIC_RELAXED, __HIP_MEMORY_SCOPE_AGENT); }
__device__ __forceinline__ unsigned xb_add(unsigned* p, unsigned v) { return __hip_atomic_fetch_add(p, v, __ATOMIC_RELAXED, __HIP_MEMORY_SCOPE_AGENT); }
__device__ __forceinline__ unsigned xb_xcc_id() { return (unsigned)__builtin_amdgcn_s_getreg((3 << 11) | 20) & 0xFu; }
#define XB_SPIN(cond, bar) do { unsigned _sp = 0; while (cond) { __builtin_amdgcn_s_sleep(1); \
    if ((++_sp & 255u) == 0u) { if (xb_ld(&(bar)[XB_TMO])) break; if (_sp > XB_SPIN_CAP) { atomicAdd(&(bar)[XB_TMO], 1u); break; } } } } while (0)

struct XcdBarrier {
    unsigned* bar; unsigned x;
    volatile LAS unsigned* st;
};

__device__ __forceinline__ XcdBarrier xcd_barrier_post(unsigned* bar, volatile LAS unsigned* st) {
    XcdBarrier b; b.bar = bar; b.x = xb_xcc_id(); b.st = st;
    if (threadIdx.x == 0) (void)xb_add(&bar[XB_XCNT(b.x)], 1u);
    return b;
}
__device__ __forceinline__ void xcd_barrier_complete(unsigned* bar, unsigned x, unsigned& nloc, unsigned& nx) {
    const unsigned G = gridDim.x * gridDim.y * gridDim.z;
    unsigned sum, cnt, mine, sp = 0u;
    for (;;) {
        sum = 0u; cnt = 0u; mine = 0u;
#pragma unroll
        for (unsigned j = 0; j < 16; ++j) { const unsigned c = xb_ld(&bar[XB_XCNT(j)]); sum += c; cnt += (c > 0u) ? 1u : 0u; mine = (j == x) ? c : mine; }
        if (sum == G) break;
        __builtin_amdgcn_s_sleep(1);
        if ((++sp & 255u) == 0u) { if (xb_ld(&bar[XB_TMO])) break; if (sp > XB_SPIN_CAP) { atomicAdd(&bar[XB_TMO], 1u); break; } }
    }
    nloc = mine > 0u ? mine : 1u; nx = cnt > 0u ? cnt : 1u;
}

__device__ __forceinline__ void xcd_barrier(const XcdBarrier& b) {
    asm volatile("s_waitcnt vmcnt(0)" ::: "memory");
    __syncthreads();
    if (threadIdx.x == 0) {
        unsigned* bar = b.bar;
        __builtin_amdgcn_s_waitcnt(0);
        unsigned nloc = b.st[0], nx = b.st[1];
        if (nloc == 0u) { xcd_barrier_complete(bar, b.x, nloc, nx); b.st[0] = nloc; b.st[1] = nx; }
        const unsigned old = xb_add(&bar[XB_XSUB(b.x)], 1u);
        const unsigned gen = old / nloc;
        if (old + 1u == (gen + 1u) * nloc) {
            __builtin_amdgcn_fence(__ATOMIC_RELEASE, "agent");
            asm volatile("s_waitcnt vmcnt(0)" ::: "memory");
            const unsigned og = xb_add(&bar[XB_TOP], 1u);
            const unsigned tg = og / nx;
            if (og + 1u == (tg + 1u) * nx) xb_add(&bar[XB_TOPGEN], 1u);
            else XB_SPIN(xb_ld(&bar[XB_TOPGEN]) == tg, bar);
            __builtin_amdgcn_fence(__ATOMIC_ACQUIRE, "agent");
            xb_add(&bar[XB_XGEN(b.x)], 1u);
            asm volatile("s_waitcnt vmcnt(0)" ::: "memory");
        } else {
            XB_SPIN(xb_ld(&bar[XB_XGEN(b.x)]) == gen, bar);
            __builtin_amdgcn_fence(__ATOMIC_ACQUIRE, "agent");
            asm volatile("s_waitcnt vmcnt(0)" ::: "memory");
        }
    }
    __syncthreads();
}

struct Args { const float* in[19]; float* out; unsigned char* ws; float inv_freq[8]; int ph_lo, ph_hi, li, pad; };
enum { I_XP = 0, I_XS, I_CK, I_CV, I_SG, I_SC, I_GMPRE, I_GMPOST, I_GFPRE, I_GFPOST, I_WIN, I_WG2, I_BG, I_GGLA, I_WOUT, I_WUP, I_CW, I_CB, I_WDN };
#define WSP(T, off) ((T*)(ws + (off)))

constexpr int PTAB_OFF = LDSCTL_OFF + 1024;
__device__ __forceinline__ const float* inptr(LAS unsigned char* lds, int k) {
    const unsigned long long v = ((const LAS unsigned long long*)(lds + PTAB_OFF))[k];
    const unsigned lo = __builtin_amdgcn_readfirstlane((unsigned)v), hi = __builtin_amdgcn_readfirstlane((unsigned)(v >> 32));
    return (const float*)(((unsigned long long)hi << 32) | lo);
}
#define INP(k) inptr(lds, (k))

__device__ __forceinline__ void tr_item(const float* W, int K, int N, const float* g, bf16* WT, LAS float* scr, int item, int nblk, int lane) {
    const int kb = item / nblk, nb = item % nblk, k0 = 64 * kb, n0 = 32 * nb;
#pragma unroll 8
    for (int i = 0; i < 32; ++i) { const int kk = 2 * i + (lane >> 5), n = n0 + (lane & 31);
        float v = (n < N) ? W[(size_t)(k0 + kk) * N + n] : 0.f; if (g) v *= g[k0 + kk]; scr[kk * 33 + (lane & 31)] = v; }
    LDS_WAIT(); asm volatile("" ::: "memory");
    const int c = lane & 7;
#pragma unroll
    for (int j = 0; j < 4; ++j) { const int n = (lane >> 3) + 8 * j; const LAS float* s = scr + (8 * c) * 33 + n;
        v4u o; o.x = pk2(s[0 * 33], s[1 * 33]); o.y = pk2(s[2 * 33], s[3 * 33]); o.z = pk2(s[4 * 33], s[5 * 33]); o.w = pk2(s[6 * 33], s[7 * 33]);
        *(GAS v4u*)(WT + (size_t)(n0 + n) * K + k0 + 8 * c) = o; }
    LDS_WAIT(); asm volatile("" ::: "memory");
}
__device__ __forceinline__ void x_row_prep(const float* xr, bf16* xb, float* rinv, int lane) {
    const GAS f32x4* x4 = (const GAS f32x4*)xr + lane;
    f32x4 v[4]; float ss = 0.f;
#pragma unroll
    for (int j = 0; j < 4; ++j) { v[j] = x4[64 * j]; ss += (v[j].x * v[j].x + v[j].y * v[j].y) + (v[j].z * v[j].z + v[j].w * v[j].w); }
    ss = wave_sum(ss);
    if (lane == 0) *rinv = 1.0f / sqrtf(ss * (1.0f / 1024.0f) + EPS);
    GAS unsigned long long* o8 = (GAS unsigned long long*)xb + lane;
#pragma unroll
    for (int j = 0; j < 4; ++j) o8[64 * j] = (unsigned long long)pk2(v[j].x, v[j].y) | ((unsigned long long)pk2(v[j].z, v[j].w) << 32);
}
__device__ __forceinline__ void phase_prologue(const Args& args, unsigned char* ws, LAS unsigned char* lds, int vcu, int G, int wave, int lane, int tid) {
    LAS float* scr = (LAS float*)(lds + wave * 16384);
    const int gw = vcu * NWAVES + wave, NGW = G * NWAVES;
    constexpr int I_IN = 16 * 97, I_OUT = 16 * 32, I_UP = 16 * 176, I_DN = 44 * 32, I_L = I_IN + I_OUT + I_UP + I_DN;
    for (int it = gw; it < NLAYER * I_L; it += NGW) {
        const int l = it / I_L; int r = it % I_L;
        if (r < I_IN) { tr_item(INP(I_WIN) + (size_t)l * 1024 * 3088, 1024, 3088, INP(I_GMPRE) + l * 1024, WSP(bf16, WS_WIN) + (size_t)l * NIN * 1024, scr, r, 97, lane); continue; }
        r -= I_IN;
        if (r < I_OUT) { tr_item(INP(I_WOUT) + (size_t)l * 1024 * 1024, 1024, 1024, nullptr, WSP(bf16, WS_WOUT) + (size_t)l * 1024 * 1024, scr, r, 32, lane); continue; }
        r -= I_OUT;
        if (r < I_UP) { tr_item(INP(I_WUP) + (size_t)l * 1024 * DFF2, 1024, DFF2, INP(I_GFPRE) + l * 1024, WSP(bf16, WS_WUP) + (size_t)l * DFF2 * 1024, scr, r, 176, lane); continue; }
        r -= I_UP;
        tr_item(INP(I_WDN) + (size_t)l * DFF * 1024, DFF, 1024, nullptr, WSP(bf16, WS_WDN) + (size_t)l * 1024 * DFF, scr, r, 32, lane);
    }
    const int gt = vcu * (NWAVES * 64) + tid, NGT = G * NWAVES * 64;
    for (int i = gt; i < NLAYER * 28672; i += NGT) { const int l = i / 28672, r = i % 28672; ((GAS v4u*)(ws + WS_WIN + (size_t)l * NIN * 2048 + (size_t)3104 * 2048))[r] = (v4u){0u, 0u, 0u, 0u}; }
    for (int i = gt; i < 16384; i += NGT) ((GAS v4u*)(ws + WS_MIX + (size_t)MT * 2048))[i] = (v4u){0u, 0u, 0u, 0u};
    for (int i = gt; i < 45056; i += NGT) ((GAS v4u*)(ws + WS_Y + (size_t)MT * DFF * 2))[i] = (v4u){0u, 0u, 0u, 0u};
    for (int i = gt; i < 4100 * 8; i += NGT) { const int p = i >> 3, d = i & 7; const int pos = p < 4096 ? p : 16384 + (p - 4096);
        const float f = ((const LAS float*)(lds + PTAB_OFF + 256))[d];
        const float ang = (float)pos * f;
        double rev = (double)ang * 0.15915494309189535; rev -= floor(rev);
        const float fr_ = (float)rev;
        WSP(float, WS_CSTAB)[2 * i] = __builtin_amdgcn_cosf(fr_); WSP(float, WS_CSTAB)[2 * i + 1] = __builtin_amdgcn_sinf(fr_); }
    for (int row = gw; row < MPAD; row += NGW) {
        bf16* xb = WSP(bf16, WS_XB) + (size_t)row * 1024; float* ri = WSP(float, WS_RINV) + row;
        if (row >= MT) { GAS unsigned long long* o8 = (GAS unsigned long long*)xb + lane;
#pragma unroll
            for (int j = 0; j < 4; ++j) o8[64 * j] = 0ull;
            if (lane == 0) *ri = 0.f; continue; }
        const float* xr = row < MP ? INP(I_XP) + (size_t)row * 1024 : INP(I_XS) + (size_t)(row - MP) * 1024;
        x_row_prep(xr, xb, ri, lane);
    }
}

#define UNPK8(dst, o, w) do { dst[(o) + 0] = bflo((w).x); dst[(o) + 1] = bfhi((w).x); dst[(o) + 2] = bflo((w).y); dst[(o) + 3] = bfhi((w).y); \
                              dst[(o) + 4] = bflo((w).z); dst[(o) + 5] = bfhi((w).z); dst[(o) + 6] = bflo((w).w); dst[(o) + 7] = bfhi((w).w); } while (0)
__device__ __forceinline__ float dot_bf16_row(const float (&q)[64], const bf16* kp) {
    const GAS v4u* k4 = (const GAS v4u*)kp; float s = 0.f;
#pragma unroll
    for (int i = 0; i < 8; ++i) { const v4u w = k4[i];
        s += q[8 * i + 0] * bflo(w.x) + q[8 * i + 1] * bfhi(w.x) + q[8 * i + 2] * bflo(w.y) + q[8 * i + 3] * bfhi(w.y)
           + q[8 * i + 4] * bflo(w.z) + q[8 * i + 5] * bfhi(w.z) + q[8 * i + 6] * bflo(w.w) + q[8 * i + 7] * bfhi(w.w); }
    return s;
}
__device__ __forceinline__ float dot_f32_row(const float (&q)[64], const float* kp) {
    const GAS f32x4* k4 = (const GAS f32x4*)kp; float s = 0.f;
#pragma unroll
    for (int i = 0; i < 16; ++i) { const f32x4 w = k4[i]; s += q[4 * i] * w.x + q[4 * i + 1] * w.y + q[4 * i + 2] * w.z + q[4 * i + 3] * w.w; }
    return s;
}
template <bool SAMPLE>
__device__ __forceinline__ void attn_item(unsigned char* ws, const float* ck, const float* cv, int l, int row, int h, LAS float* pbuf, int lane) {
    const bf16* QA = WSP(bf16, WS_QA); const bf16* KA = WSP(bf16, WS_KA); const bf16* VA = WSP(bf16, WS_VA);
    float q[64];
    { const GAS v4u* qp = (const GAS v4u*)(QA + (size_t)row * 512 + h * 64);
#pragma unroll
      for (int i = 0; i < 8; ++i) { const v4u w = qp[i]; UNPK8(q, 8 * i, w); } }
    int t = 0, kbase = 0, sb = 0, si = 0;
    if (!SAMPLE) { t = row & 4095; kbase = row & ~4095; } else { sb = (row - MP) >> 2; si = (row - MP) & 3; }
    const size_t cbase = (((size_t)l * 32 + sb) * 2048) * 512 + h * 64;
    float mx = -INFINITY;
#pragma unroll 1
    for (int it = 0; it < 7; ++it) {
        const int e = lane + 64 * it; const int ec = e < 387 ? e : 386;
        const int p = ec >= 258 ? 2 : (ec >= 129 ? 1 : 0); const int j = ec - 129 * p; const int dil = 1 << (2 * p);
        bool valid = e < 387; float s;
        if (!SAMPLE) { int pos = t - dil * j; valid = valid && pos >= 0; pos = pos < 0 ? 0 : pos;
            s = dot_bf16_row(q, KA + (size_t)(kbase + pos) * 512 + h * 64); }
        else { const int idx = 2048 + si - dil * j;
            if (idx >= 2048) s = dot_bf16_row(q, KA + (size_t)(MP + sb * 4 + (idx - 2048)) * 512 + h * 64);
            else s = dot_f32_row(q, ck + cbase + (size_t)idx * 512); }
        s = valid ? s : -INFINITY; pbuf[e] = s; mx = fmaxf(mx, s);
    }
    mx = wave_max(mx);
    float ls = 0.f;
#pragma unroll
    for (int it = 0; it < 7; ++it) { const float pe = __expf(pbuf[lane + 64 * it] - mx); ls += pe; pbuf[lane + 64 * it] = pe; }
    ls = wave_sum(ls);
    LDS_WAIT(); asm volatile("" ::: "memory");
    float o = 0.f;
    for (int p = 0; p < 3; ++p) { const int dil = 1 << (2 * p);
        int jmax = 128; if (!SAMPLE) { const int tj = t / dil; jmax = tj < 128 ? tj : 128; }
#pragma unroll 4
        for (int j = 0; j <= jmax; ++j) { const float pe = pbuf[p * 129 + j]; float v;
            if (!SAMPLE) v = bf2f(VA[(size_t)(kbase + t - dil * j) * 512 + h * 64 + lane]);
            else { const int idx = 2048 + si - dil * j;
                if (idx >= 2048) v = bf2f(VA[(size_t)(MP + sb * 4 + (idx - 2048)) * 512 + h * 64 + lane]); else v = cv[cbase + (size_t)idx * 512 + lane]; }
            o += pe * v; } }
    o = o / ls;
    WSP(bf16, WS_MIX)[(size_t)row * 1024 + h * 64 + lane] = (bf16)f2bf(o);
    LDS_WAIT(); asm volatile("" ::: "memory");
}

__device__ __forceinline__ void gla_unit_geom(int u, int& R0, int& c, int& h) {
    if (u < 1024) { const int bh = u >> 6, n = u & 63; h = bh & 3; R0 = (bh >> 2) * 4096 + n * 64; c = 64; }
    else { const int s = u - 1024; h = s & 3; R0 = MP + (s >> 2) * 4; c = 4; }
}
__device__ __forceinline__ void gla_local_unit(const Args& args, unsigned char* ws, LAS unsigned char* lds, int l, int u, int tid) {
    LAS float* sB = (LAS float*)lds; LAS float* sK = (LAS float*)(lds + 16384); LAS float* sV = (LAS float*)(lds + 32768);
    int R0, c, h; gla_unit_geom(u, R0, c, h);
    const float* GL = WSP(float, WS_GL); const float* wg2 = INP(I_WG2) + (size_t)l * 16 * 256; const float* bg = INP(I_BG) + l * 256;
    for (int idx = tid; idx < c * 64; idx += NWAVES * 64) { const int t = idx >> 6, kk = idx & 63; const float* gl = GL + (size_t)(R0 + t) * 16;
        float z = bg[h * 64 + kk];
#pragma unroll
        for (int r = 0; r < 16; ++r) z += gl[r] * wg2[r * 256 + h * 64 + kk];
        const float ls = fminf(z, 0.f) - __logf(1.0f + __expf(-fabsf(z)));
        sB[idx] = ls * (1.0f / 16.0f); }
    __syncthreads();
    if (tid < 64) { float a = 0.f; for (int t = 0; t < c; ++t) { a += sB[t * 64 + tid]; sB[t * 64 + tid] = a; } }
    __syncthreads();
    for (int idx = tid; idx < c * 64; idx += NWAVES * 64) { const int t = idx >> 6, kk = idx & 63; const float bb = sB[idx];
        WSP(float, WS_BCUM)[(size_t)(R0 + t) * 256 + h * 64 + kk] = bb;
        sK[idx] = bf2f(WSP(bf16, WS_KB)[(size_t)(R0 + t) * 256 + h * 64 + kk]) * __expf(sB[(c - 1) * 64 + kk] - bb); }
    for (int idx = tid; idx < c * 128; idx += NWAVES * 64) { const int t = idx >> 7, vv = idx & 127; sV[idx] = bf2f(WSP(bf16, WS_VB)[(size_t)(R0 + t) * 512 + h * 128 + vv]); }
    if (tid < 64) WSP(float, WS_GDEC)[u * 64 + tid] = __expf(sB[(c - 1) * 64 + tid]);
    __syncthreads();
    { const int kk = tid >> 3, v0 = (tid & 7) * 16; float acc[16];
#pragma unroll
      for (int i = 0; i < 16; ++i) acc[i] = 0.f;
      for (int s = 0; s < c; ++s) { const float kv = sK[s * 64 + kk];
#pragma unroll
          for (int i = 0; i < 16; ++i) acc[i] += kv * sV[s * 128 + v0 + i]; }
      GAS f32x4* up = (GAS f32x4*)(WSP(float, WS_UST) + (size_t)u * 8192 + kk * 128 + v0);
#pragma unroll
      for (int i = 0; i < 4; ++i) up[i] = (f32x4){acc[4 * i], acc[4 * i + 1], acc[4 * i + 2], acc[4 * i + 3]}; }
    __syncthreads();
}

__device__ __forceinline__ void gla_scan(const Args& args, unsigned char* ws, LAS unsigned char* lds, int l, int vcu, int G, int tid) {
    const int gt = vcu * (NWAVES * 64) + tid, NGT = G * NWAVES * 64;
    const float* UST = WSP(float, WS_UST); const float* GDEC = WSP(float, WS_GDEC); float* SPREV = WSP(float, WS_SPREV);
    for (int g = gt; g < 16 * 8192; g += NGT) { const int sh = g >> 13, e = g & 8191, kk = e >> 7; float S = 0.f;
#pragma unroll 8
        for (int n = 0; n < 64; ++n) { const int u = sh * 64 + n; SPREV[(size_t)u * 8192 + e] = S; S = GDEC[u * 64 + kk] * S + UST[(size_t)u * 8192 + e]; }
        args.out[O_SGP + ((size_t)l * 16 + sh) * 8192 + e] = S; }
    for (int g = gt; g < 128 * 8192; g += NGT) { const int shs = g >> 13, e = g & 8191, kk = e >> 7, u = 1024 + shs;
        const float S0 = INP(I_SG)[((size_t)l * 128 + shs) * 8192 + e];
        args.out[O_SGS + ((size_t)l * 128 + shs) * 8192 + e] = GDEC[u * 64 + kk] * S0 + UST[(size_t)u * 8192 + e]; }
}

__device__ __forceinline__ void gla_out_unit(const Args& args, unsigned char* ws, LAS unsigned char* lds, int l, int u, int tid) {
    LAS float* sQ = (LAS float*)lds; LAS float* sK = (LAS float*)(lds + 16384); LAS float* sV = (LAS float*)(lds + 32768); LAS float* sS = (LAS float*)(lds + 65536); LAS float* sA = (LAS float*)(lds + 98304);
    int R0, c, h; gla_unit_geom(u, R0, c, h);
    for (int idx = tid; idx < c * 64; idx += NWAVES * 64) { const int t = idx >> 6, kk = idx & 63; const size_t off = (size_t)(R0 + t) * 256 + h * 64 + kk;
        const float bb = WSP(float, WS_BCUM)[off];
        sQ[idx] = bf2f(WSP(bf16, WS_QB)[off]) * __expf(bb); sK[idx] = bf2f(WSP(bf16, WS_KB)[off]) * __expf(-bb); }
    for (int idx = tid; idx < c * 128; idx += NWAVES * 64) { const int t = idx >> 7, vv = idx & 127; sV[idx] = bf2f(WSP(bf16, WS_VB)[(size_t)(R0 + t) * 512 + h * 128 + vv]); }
    { const float* sp = u < 1024 ? WSP(float, WS_SPREV) + (size_t)u * 8192 : INP(I_SG) + ((size_t)l * 128 + (u - 1024)) * 8192;
      for (int idx = tid; idx < 8192; idx += NWAVES * 64) sS[idx] = sp[idx]; }
    __syncthreads();
    for (int idx = tid; idx < c * c; idx += NWAVES * 64) { const int t = idx / c, s = idx - t * c; float a = 0.f;
        if (s <= t) { for (int kk = 0; kk < 64; ++kk) a += sQ[t * 64 + kk] * sK[s * 64 + kk]; }
        sA[t * 64 + s] = a; }
    __syncthreads();
    { const int t = tid >> 3, v0 = (tid & 7) * 16;
      if (t < c) { float acc[16];
#pragma unroll
        for (int i = 0; i < 16; ++i) acc[i] = 0.f;
        for (int s = 0; s <= t; ++s) { const float a = sA[t * 64 + s];
#pragma unroll
            for (int i = 0; i < 16; ++i) acc[i] += a * sV[s * 128 + v0 + i]; }
        for (int kk = 0; kk < 64; ++kk) { const float qv = sQ[t * 64 + kk];
#pragma unroll
            for (int i = 0; i < 16; ++i) acc[i] += qv * sS[kk * 128 + v0 + i]; }
        float ss = 0.f;
#pragma unroll
        for (int i = 0; i < 16; ++i) ss += acc[i] * acc[i];
        ss += __shfl_xor(ss, 1); ss += __shfl_xor(ss, 2); ss += __shfl_xor(ss, 4);
        const float rn = 1.0f / sqrtf(ss * (1.0f / 128.0f) + EPS);
        const int row = R0 + t; const float* gg = INP(I_GGLA) + l * 128 + v0; const bf16* rb = WSP(bf16, WS_RB) + (size_t)row * 512 + h * 128 + v0;
        unsigned w[8];
#pragma unroll
        for (int i = 0; i < 16; i += 2) { const float r0 = bf2f(rb[i]), r1 = bf2f(rb[i + 1]);
            const float y0 = acc[i] * rn * gg[i] * (r0 / (1.0f + __expf(-r0))), y1 = acc[i + 1] * rn * gg[i + 1] * (r1 / (1.0f + __expf(-r1)));
            w[i >> 1] = pk2(y0, y1); }
        GAS v4u* mp = (GAS v4u*)(WSP(bf16, WS_MIX) + (size_t)row * 1024 + 512 + h * 128 + v0);
        mp[0] = (v4u){w[0], w[1], w[2], w[3]}; mp[1] = (v4u){w[4], w[5], w[6], w[7]}; } }
    __syncthreads();
}

__device__ __forceinline__ void row_pass(const Args& args, unsigned char* ws, LAS unsigned char* lds, int l, int second, int vcu, int G, int wave, int lane) {
    const int gw = vcu * NWAVES + wave, NGW = G * NWAVES;
    const float* g = INP(second ? I_GFPOST : I_GMPOST) + l * 1024;
    const bool from_input = (l == 0 && !second), final = (l == NLAYER - 1 && second);
    f32x4 gv[4];
#pragma unroll
    for (int j = 0; j < 4; ++j) gv[j] = ((const GAS f32x4*)g)[lane + 64 * j];
    for (int row = gw; row < MT; row += NGW) {
        const float* xr = from_input ? (row < MP ? INP(I_XP) + (size_t)row * 1024 : INP(I_XS) + (size_t)(row - MP) * 1024) : WSP(float, WS_XRES) + (size_t)row * 1024;
        const GAS f32x4* x4 = (const GAS f32x4*)xr + lane; const GAS f32x4* m4 = (const GAS f32x4*)(WSP(float, WS_MBUF) + (size_t)row * 1024) + lane;
        f32x4 xv[4], mv[4]; float ss = 0.f;
#pragma unroll
        for (int j = 0; j < 4; ++j) { xv[j] = x4[64 * j]; mv[j] = m4[64 * j]; ss += (mv[j].x * mv[j].x + mv[j].y * mv[j].y) + (mv[j].z * mv[j].z + mv[j].w * mv[j].w); }
        ss = wave_sum(ss);
        const float rm = 1.0f / sqrtf(ss * (1.0f / 1024.0f) + EPS);
        float s2 = 0.f;
#pragma unroll
        for (int j = 0; j < 4; ++j) { xv[j] = xv[j] + mv[j] * rm * gv[j]; s2 += (xv[j].x * xv[j].x + xv[j].y * xv[j].y) + (xv[j].z * xv[j].z + xv[j].w * xv[j].w); }
        if (final) { float* orow = row < MP ? args.out + O_YP + (size_t)row * 1024 : args.out + O_YS + (size_t)(row - MP) * 1024;
#pragma unroll
            for (int j = 0; j < 4; ++j) ((GAS f32x4*)orow)[lane + 64 * j] = xv[j]; }
        else { s2 = wave_sum(s2);
            if (lane == 0) WSP(float, WS_RINV)[row] = 1.0f / sqrtf(s2 * (1.0f / 1024.0f) + EPS);
            GAS f32x4* xo = (GAS f32x4*)(WSP(float, WS_XRES) + (size_t)row * 1024) + lane; GAS unsigned long long* o8 = (GAS unsigned long long*)(WSP(bf16, WS_XB) + (size_t)row * 1024) + lane;
#pragma unroll
            for (int j = 0; j < 4; ++j) { xo[64 * j] = xv[j]; o8[64 * j] = (unsigned long long)pk2(xv[j].x, xv[j].y) | ((unsigned long long)pk2(xv[j].z, xv[j].w) << 32); } }
    }
}

__device__ __forceinline__ float gelu_tanh(float x) { const float z = 0.7978845608028654f * (x + 0.044715f * x * x * x); const float e = __expf(2.0f * z); const float th = 1.0f - 2.0f / (e + 1.0f); return 0.5f * x * (1.0f + th); }
__device__ __forceinline__ void load8_u(float (&d)[8], const bf16* U, int row, int col) { const v4u w = *(const GAS v4u*)(U + (size_t)row * DFF2 + col); UNPK8(d, 0, w); }
__device__ __forceinline__ void load8_f(float (&d)[8], const float* p) { const f32x4 a = ((const GAS f32x4*)p)[0], b = ((const GAS f32x4*)p)[1]; d[0] = a.x; d[1] = a.y; d[2] = a.z; d[3] = a.w; d[4] = b.x; d[5] = b.y; d[6] = b.z; d[7] = b.w; }
__device__ __forceinline__ void conv_geglu(const Args& args, unsigned char* ws, LAS unsigned char* lds, int l, int vcu, int G, int tid) {
    const int gt = vcu * (NWAVES * 64) + tid, NGT = G * NWAVES * 64;
    const bf16* U = WSP(bf16, WS_U); const float* cw = INP(I_CW) + (size_t)l * 3 * DFF2; const float* cb = INP(I_CB) + (size_t)l * DFF2;
    for (int it = gt; it < MT * 352; it += NGT) { const int row = it / 352, c8 = (it - row * 352) * 8;
        int t; const float* st = nullptr;
        if (row < MP) t = row & 4095; else { t = (row - MP) & 3; st = INP(I_SC) + ((size_t)l * 32 + ((row - MP) >> 2)) * 2 * DFF2; }
        float res[2][8];
#pragma unroll
        for (int half = 0; half < 2; ++half) { const int col = half * DFF + c8;
            float u2[8], u1[8], u0[8], w0[8], w1[8], w2[8], b[8];
            load8_u(u2, U, row, col);
            if (t >= 1) load8_u(u1, U, row - 1, col); else if (st) load8_f(u1, st + DFF2 + col); else {
#pragma unroll
                for (int i = 0; i < 8; ++i) u1[i] = 0.f; }
            if (t >= 2) load8_u(u0, U, row - 2, col); else if (st) load8_f(u0, st + (size_t)t * DFF2 + col); else {
#pragma unroll
                for (int i = 0; i < 8; ++i) u0[i] = 0.f; }
            load8_f(w0, cw + col); load8_f(w1, cw + DFF2 + col); load8_f(w2, cw + 2 * DFF2 + col); load8_f(b, cb + col);
#pragma unroll
            for (int i = 0; i < 8; ++i) res[half][i] = b[i] + w0[i] * u0[i] + w1[i] * u1[i] + w2[i] * u2[i]; }
        unsigned w[4];
#pragma unroll
        for (int i = 0; i < 8; i += 2) w[i >> 1] = pk2(gelu_tanh(res[0][i]) * res[1][i], gelu_tanh(res[0][i + 1]) * res[1][i + 1]);
        *(GAS v4u*)(WSP(bf16, WS_Y) + (size_t)row * DFF + c8) = (v4u){w[0], w[1], w[2], w[3]}; }
}

#ifndef MK_N_LAUNCHES
#define MK_N_LAUNCHES 1
#endif
constexpr int N_PHASES = 1 + 10 * NLAYER;
__global__ void __launch_bounds__(NWAVES * 64, 2) mk_fwd(Args args) {
    extern __shared__ __attribute__((aligned(16))) unsigned char lds_raw[];
    LAS unsigned char* lds = (LAS unsigned char*)lds_raw;
    volatile LAS unsigned* MISC = (volatile LAS unsigned*)(lds + MISC_OFF);
    const int tid0 = threadIdx.x;
    const int G = gridDim.x;
    unsigned char* ws0 = args.ws;
    for (int u = tid0; u < (LDS_BYTES - LDSCTL_OFF) / 4; u += NWAVES * 64) ((LAS unsigned*)(lds + LDSCTL_OFF))[u] = 0u;
    __syncthreads();
    if (tid0 == 0) { LAS unsigned long long* pt = (LAS unsigned long long*)(lds + PTAB_OFF);
#pragma unroll
        for (int k = 0; k < 19; ++k) pt[k] = (unsigned long long)args.in[k];
#pragma unroll
        for (int k = 0; k < 8; ++k) ((LAS float*)(lds + PTAB_OFF + 256))[k] = args.inv_freq[k]; }
    __syncthreads();
    const int lo = args.ph_lo, hi = args.ph_hi;
    XcdBarrier bar; bar.bar = (unsigned*)(ws0 + WS_CTL) + CW_BAR + args.li * XCD_BAR_WORDS; bar.x = 0; bar.st = nullptr;
    if (hi - lo > 1) bar = xcd_barrier_post((unsigned*)(ws0 + WS_CTL) + CW_BAR + args.li * XCD_BAR_WORDS, MISC + 8);

    for (int ph = lo; ph < hi; ++ph) {
        int tid = threadIdx.x; asm volatile("" : "+v"(tid));
        unsigned char* ws = ws0; asm volatile("" : "+s"(ws));
        int bx = blockIdx.x; asm volatile("" : "+s"(bx));
        const int lane = tid & 63, wave = __builtin_amdgcn_readfirstlane(tid >> 6);
        const int vcu = (G % 8 == 0) ? (bx % 8) * (G / 8) + bx / 8 : bx;
        if (ph == 0) { phase_prologue(args, ws, lds, vcu, G, wave, lane, tid); }
        else {
            const int l = (ph - 1) / 10, s = (ph - 1) % 10;
            if (s == 0) {
                pg8::Gemm g{WSP(pg8::bf16_t, WS_XB), WSP(pg8::bf16_t, WS_WIN) + (size_t)l * NIN * 1024, MPAD, NIN, 1024}; pg8::StaticOrder S; S.init(MPAD, NIN, G, bx);
                pg8::EpiProj E{ws, args.out, l};
                pg8::gemm_phase<pg8::EpiProj, pg8::StaticOrder, PG8_ALIGN, PG8_SP2>(lds + RING_OFF, g, S, E);
            } else if (s == 1) {
                LAS float* pbuf = (LAS float*)(lds + wave * 2048);
                const int gw = vcu * NWAVES + wave, NGW = G * NWAVES;
                for (int it = gw; it < MP * 8; it += NGW) attn_item<false>(ws, INP(I_CK), INP(I_CV), l, it >> 3, it & 7, pbuf, lane);
                for (int it = gw; it < MS * 8; it += NGW) attn_item<true>(ws, INP(I_CK), INP(I_CV), l, MP + (it >> 3), it & 7, pbuf, lane);
                __syncthreads();
                for (int u = vcu; u < GLA_UNITS; u += G) gla_local_unit(args, ws, lds, l, u, tid);
            } else if (s == 2) { gla_scan(args, ws, lds, l, vcu, G, tid); }
            else if (s == 3) { for (int u = vcu; u < GLA_UNITS; u += G) gla_out_unit(args, ws, lds, l, u, tid); }
            else if (s == 4 || s == 8) {
                pg8::Gemm g; if (s == 4) g = pg8::Gemm{WSP(pg8::bf16_t, WS_MIX), WSP(pg8::bf16_t, WS_WOUT) + (size_t)l * 1024 * 1024, MPAD, 1024, 1024};
                             else g = pg8::Gemm{WSP(pg8::bf16_t, WS_Y), WSP(pg8::bf16_t, WS_WDN) + (size_t)l * 1024 * DFF, MPAD, 1024, DFF};
                pg8::StaticOrder S; S.init(MPAD, 1024, G, bx);
                pg8::EpiF32 E{WSP(float, WS_MBUF), 1024};
                pg8::gemm_phase<pg8::EpiF32, pg8::StaticOrder, PG8_ALIGN, PG8_SP2>(lds + RING_OFF, g, S, E);
            } else if (s == 5 || s == 9) { row_pass(args, ws, lds, l, s == 9 ? 1 : 0, vcu, G, wave, lane); }
            else if (s == 6) {
                pg8::Gemm g{WSP(pg8::bf16_t, WS_XB), WSP(pg8::bf16_t, WS_WUP) + (size_t)l * DFF2 * 1024, MPAD, DFF2, 1024}; pg8::StaticOrder S; S.init(MPAD, DFF2, G, bx);
                pg8::EpiUp E{ws, args.out, l};
                pg8::gemm_phase<pg8::EpiUp, pg8::StaticOrder, PG8_ALIGN, PG8_SP2>(lds + RING_OFF, g, S, E);
            } else if (s == 7) { conv_geglu(args, ws, lds, l, vcu, G, tid); }
        }
        if (ph + 1 < hi) xcd_barrier(bar);
    }
}

extern "C" void kernel_launch(void* const* d_in, const int* in_sizes, int n_in, void* d_out, int out_size, void* d_ws, size_t ws_size, hipStream_t stream) {
    static int grid = 0;
    if (grid == 0) {
        if (n_in != 19 || out_size != (int)O_END || ws_size < WS_END) { fprintf(stderr, "kernel_launch: unexpected shapes: n_in %d out %d ws %zu; nothing launched\n", n_in, out_size, ws_size); grid = -1; return; }
        int dev = 0, cus = 0, per_cu = 0;
        if (hipGetDevice(&dev) != hipSuccess || hipDeviceGetAttribute(&cus, hipDeviceAttributeMultiprocessorCount, dev) != hipSuccess) { fprintf(stderr, "kernel_launch: device query failed\n"); grid = -1; return; }
        if (hipFuncSetAttribute((const void*)mk_fwd, hipFuncAttributeMaxDynamicSharedMemorySize, LDS_BYTES) != hipSuccess) { fprintf(stderr, "kernel_launch: hipFuncSetAttribute failed\n"); grid = -1; return; }
        if (hipOccupancyMaxActiveBlocksPerMultiprocessor(&per_cu, (const void*)mk_fwd, NWAVES * 64, LDS_BYTES) != hipSuccess || per_cu < 1) { fprintf(stderr, "kernel_launch: occupancy query reports %d blocks per CU\n", per_cu); }
        (void)hipGetLastError();
        grid = cus;
    }
    if (grid < 0) return;
    if (hipMemsetAsync((char*)d_ws + WS_CTL, 0, CTL_ZERO_BYTES, stream) != hipSuccess) { fprintf(stderr, "kernel_launch: memset failed\n"); return; }
    Args a{};
    for (int i = 0; i < 19; ++i) a.in[i] = (const float*)d_in[i];
    a.out = (float*)d_out; a.ws = (unsigned char*)d_ws;
    for (int d = 0; d < 8; ++d) a.inv_freq[d] = (float)pow(500000.0, -(double)d / 8.0);
#if MK_N_LAUNCHES == 1
    a.ph_lo = 0; a.ph_hi = N_PHASES; a.li = 0;
    hipLaunchKernelGGL(mk_fwd, dim3(grid), dim3(NWAVES * 64), LDS_BYTES, stream, a);
#else
    for (int ph = 0; ph < N_PHASES; ++ph) { a.ph_lo = ph; a.ph_hi = ph + 1; a.li = 0; hipLaunchKernelGGL(mk_fwd, dim3(grid), dim3(NWAVES * 64), LDS_BYTES, stream, a); }
#endif
    const hipError_t le = hipPeekAtLastError();
    if (le != hipSuccess) fprintf(stderr, "kernel_launch: launch failed: %s\n", hipGetErrorName(le));
}
```

```cpp
#define MK_N_LAUNCHES 1
#include <hip/hip_runtime.h>
#include <cstdio>
#include <cstdint>
#include <cmath>
namespace pg8 {
#define PG8_LAS __attribute__((address_space(3)))
typedef unsigned short bf16_t;
typedef short bf16x8 __attribute__((ext_vector_type(8)));
typedef float f32x4 __attribute__((ext_vector_type(4)));
typedef unsigned u32x4 __attribute__((ext_vector_type(4)));
constexpr int BM = 256, BK = 64, HALF = 128, HTB = HALF * BK * 2  , STAGE_BYTES = 8 * HTB, NXCD = 8, WGM = 8;

__host__ __device__ __forceinline__ int lds_byte(int r, int c) { const int st = (r >> 4) * 2 + (c >> 5), rr = r & 15, cc = c & 31, ob = rr * 64 + cc * 2; return st * 1024 + (ob ^ (((ob >> 9) & 1) << 5)); }
__host__ __device__ __forceinline__ void stage_rc(int b, int& R, int& C) { const int st = b / 1024, sb = b % 1024, swz = sb ^ (((sb >> 9) & 1) << 5); R = (st >> 1) * 16 + swz / 64; C = (st & 1) * 32 + (swz % 64) / 2; }
__host__ __device__ __forceinline__ int perm32(int rho) { const int n = rho >> 4, i = rho & 15; return 8 * (i >> 2) + 4 * n + (i & 3); }

struct Unit { int pm, pn; };
struct Gemm { const bf16_t* A; const bf16_t* Bt; int M, N, K; };

struct StaticOrder {
    int nM, nN, nwg, G, c;
    __host__ __device__ void init(int M, int N, int G_, int c_) { nM = M / BM; nN = N / BM; nwg = nM * nN; G = G_; c = c_; }
    __host__ __device__ bool next(int i, Unit& u) const {
        const long L = (long)i * G + c; if (L >= nwg) return false;
        int wgid = (int)L; { const int q = nwg / NXCD, r = nwg % NXCD, xcd = wgid % NXCD, off = wgid / NXCD; wgid = (xcd < r ? xcd * (q + 1) : r * (q + 1) + (xcd - r) * q) + off; }
        const int nig = WGM * nN, gid = wgid / nig, fm = gid * WGM, gsz = (nM - fm) < WGM ? (nM - fm) : WGM;
        u.pm = fm + ((wgid % nig) % gsz); u.pn = (wgid % nig) / gsz; return true;
    }
    __device__ __forceinline__ void a_ready(const Unit&) const {}
    __device__ __forceinline__ void done(const Unit&) const {}
};


__device__ __forceinline__ unsigned cvt_pk_bf16(float lo, float hi) { unsigned r; asm volatile("v_cvt_pk_bf16_f32 %0, %1, %2" : "=v"(r) : "v"(lo), "v"(hi)); return r; }


constexpr size_t EP_MiB = 1u << 20;
constexpr size_t EP_CSTAB = 51 * EP_MiB, EP_RINV = 52 * EP_MiB, EP_GL = 53 * EP_MiB, EP_QA = 154 * EP_MiB, EP_KA = 171 * EP_MiB, EP_VA = 188 * EP_MiB, EP_QB = 205 * EP_MiB, EP_KB = 214 * EP_MiB, EP_VB = 223 * EP_MiB, EP_RB = 240 * EP_MiB, EP_U = 440 * EP_MiB;
constexpr size_t EP_O_KP = 16908288, EP_O_VP = 25296896, EP_O_CP = 33947648, EP_O_KS = 34037760, EP_O_VS = 34168832, EP_O_CS = 36397056;
constexpr int ROWS_P = 16384, ROWS_T = 16512;

struct EpiProj {
    static constexpr bool PERM = true, AFTER_DRAIN = false;
    unsigned char* ws; float* out; int l;
    __device__ __forceinline__ void operator()(const f32x4 (&acc)[2][2][4][2], const Unit& u, int wr, int wc, int fr, int fq) const {
        const float* rinv = (const float*)(ws + EP_RINV); const float* cs = (const float*)(ws + EP_CSTAB);
        bf16_t* QA = (bf16_t*)(ws + EP_QA); bf16_t* KA = (bf16_t*)(ws + EP_KA); bf16_t* VA = (bf16_t*)(ws + EP_VA); bf16_t* QB = (bf16_t*)(ws + EP_QB); bf16_t* KB = (bf16_t*)(ws + EP_KB);
        bf16_t* VB = (bf16_t*)(ws + EP_VB); bf16_t* RB = (bf16_t*)(ws + EP_RB); float* GL = (float*)(ws + EP_GL);
        float* okp = out + EP_O_KP + (size_t)l * 4 * 2048 * 512; float* ovp = out + EP_O_VP + (size_t)l * 4 * 2048 * 512; float* oks = out + EP_O_KS + (size_t)l * 128 * 512; float* ovs = out + EP_O_VS + (size_t)l * 128 * 512;
        const int pn = u.pn;
        const bool rope_wave = (pn < 4) && ((wc & 1) == 0);
#pragma unroll
        for (int ai = 0; ai < 2; ++ai)
#pragma unroll
            for (int m = 0; m < 4; ++m) {
                const int row = u.pm * BM + ai * HALF + wr * 64 + m * 16 + fr;
                const float rs = rinv[row];
                const int pidx = row < ROWS_P ? (row & 4095) : (row < ROWS_T ? 4096 + ((row - ROWS_P) & 3) : 0);
                const bool ok = row < ROWS_T;
#pragma unroll
                for (int bj = 0; bj < 2; ++bj) {
                    const int c0 = pn * BM + bj * HALF + wc * 32 + 8 * fq;
                    float v[8];
#pragma unroll
                    for (int j = 0; j < 4; ++j) { v[j] = acc[ai][bj][m][0][j] * rs; v[4 + j] = acc[ai][bj][m][1][j] * rs; }
                    if (rope_wave) {
                        float o[8];
#pragma unroll
                        for (int j = 0; j < 8; ++j) o[j] = __shfl_xor(v[j], 16);
                        if (fq < 2) {
                            const f32x4* cp = (const f32x4*)(cs + (size_t)pidx * 16);
                            const f32x4 c01 = cp[0], c23 = cp[1], c45 = cp[2], c67 = cp[3];
                            const float cc[8] = {c01[0], c01[2], c23[0], c23[2], c45[0], c45[2], c67[0], c67[2]};
                            const float ss[8] = {c01[1], c01[3], c23[1], c23[3], c45[1], c45[3], c67[1], c67[3]};
                            const float sg = fq == 0 ? -1.f : 1.f;
#pragma unroll
                            for (int j = 0; j < 8; ++j) v[j] = v[j] * cc[j] + sg * o[j] * ss[j];
                        }
                    }
                    if (pn < 2 || pn == 6) {
#pragma unroll
                        for (int j = 0; j < 8; ++j) v[j] *= (pn < 2 ? 0.18033688011112042f : 0.125f);
                    }
                    u32x4 w; w.x = cvt_pk_bf16(v[0], v[1]); w.y = cvt_pk_bf16(v[2], v[3]); w.z = cvt_pk_bf16(v[4], v[5]); w.w = cvt_pk_bf16(v[6], v[7]);
                    if (!ok) continue;
                    if (pn < 2) { *(u32x4*)(QA + (size_t)row * 512 + c0) = w; }
                    else if (pn < 6) {
                        const bool isk = pn < 4; const int c = c0 - (isk ? 512 : 1024);
                        *(u32x4*)((isk ? KA : VA) + (size_t)row * 512 + c) = w;
                        float* op = nullptr;
                        if (row < ROWS_P) { const int t = row & 4095; if (t >= 2048) op = (isk ? okp : ovp) + ((size_t)((row >> 12) * 2048 + (t - 2048))) * 512 + c; }
                        else op = (isk ? oks : ovs) + (size_t)(row - ROWS_P) * 512 + c;
                        if (op) { *(f32x4*)op = (f32x4){v[0], v[1], v[2], v[3]}; *(f32x4*)(op + 4) = (f32x4){v[4], v[5], v[6], v[7]}; }
                    }
                    else if (pn == 6) { *(u32x4*)(QB + (size_t)row * 256 + (c0 - 1536)) = w; }
                    else if (pn == 7) { *(u32x4*)(KB + (size_t)row * 256 + (c0 - 1792)) = w; }
                    else if (pn < 10) { *(u32x4*)(VB + (size_t)row * 512 + (c0 - 2048)) = w; }
                    else if (pn < 12) { *(u32x4*)(RB + (size_t)row * 512 + (c0 - 2560)) = w; }
                    else { const int c = c0 - 3072; if (c < 16) { float* gp = GL + (size_t)row * 16 + c; *(f32x4*)gp = (f32x4){v[0], v[1], v[2], v[3]}; *(f32x4*)(gp + 4) = (f32x4){v[4], v[5], v[6], v[7]}; } }
                }
            }
    }
};

struct EpiF32 {
    static constexpr bool PERM = false, AFTER_DRAIN = false;
    float* O; int ldc;
    __device__ __forceinline__ void operator()(const f32x4 (&acc)[2][2][4][2], const Unit& u, int wr, int wc, int fr, int fq) const {
        const int col0 = u.pn * BM + wc * 32 + 4 * fq;
#pragma unroll
        for (int ai = 0; ai < 2; ++ai)
#pragma unroll
            for (int m = 0; m < 4; ++m) {
                const int row = u.pm * BM + ai * HALF + wr * 64 + m * 16 + fr;
                if (row >= ROWS_T) continue;
                float* rp = O + (size_t)row * ldc + col0;
#pragma unroll
                for (int bj = 0; bj < 2; ++bj)
#pragma unroll
                    for (int n = 0; n < 2; ++n) *(f32x4*)(rp + bj * HALF + n * 16) = acc[ai][bj][m][n];
            }
    }
};

struct EpiUp {
    static constexpr bool PERM = true, AFTER_DRAIN = false;
    unsigned char* ws; float* out; int l;
    __device__ __forceinline__ void operator()(const f32x4 (&acc)[2][2][4][2], const Unit& u, int wr, int wc, int fr, int fq) const {
        const float* rinv = (const float*)(ws + EP_RINV); bf16_t* U = (bf16_t*)(ws + EP_U);
        float* ocp = out + EP_O_CP + (size_t)l * 4 * 2 * 5632; float* ocs = out + EP_O_CS + (size_t)l * 32 * 2 * 5632;
#pragma unroll
        for (int ai = 0; ai < 2; ++ai)
#pragma unroll
            for (int m = 0; m < 4; ++m) {
                const int row = u.pm * BM + ai * HALF + wr * 64 + m * 16 + fr;
                if (row >= ROWS_T) continue;
                const float rs = rinv[row];
                float* op = nullptr;
                if (row < ROWS_P) { const int t = row & 4095; if (t >= 4094) op = ocp + (size_t)((row >> 12) * 2 + (t - 4094)) * 5632; }
                else { const int i = (row - ROWS_P) & 3; if (i >= 2) op = ocs + (size_t)(((row - ROWS_P) >> 2) * 2 + (i - 2)) * 5632; }
#pragma unroll
                for (int bj = 0; bj < 2; ++bj) {
                    const int c0 = u.pn * BM + bj * HALF + wc * 32 + 8 * fq;
                    const f32x4 v0 = acc[ai][bj][m][0] * rs, v1 = acc[ai][bj][m][1] * rs;
                    u32x4 w; w.x = cvt_pk_bf16(v0[0], v0[1]); w.y = cvt_pk_bf16(v0[2], v0[3]); w.z = cvt_pk_bf16(v1[0], v1[1]); w.w = cvt_pk_bf16(v1[2], v1[3]);
                    *(u32x4*)(U + (size_t)row * 5632 + c0) = w;
                    if (op) { *(f32x4*)(op + c0) = v0; *(f32x4*)(op + c0 + 4) = v1; }
                }
            }
    }
};

template <class Epi, class Sched, bool ALIGN_EPI = false, bool SP2 = false>
__device__ __forceinline__ void gemm_phase(PG8_LAS unsigned char* lds, const Gemm g, const Sched& S, const Epi& E) {
    const int tid = threadIdx.x, wid = __builtin_amdgcn_readfirstlane(tid >> 6), lane = tid & 63, wr = wid >> 2, wc = wid & 3, fr = lane & 15, fq = lane >> 4;
    const int K = g.K, nt = K / BK;
    unsigned voffA[2], voffB[2];
#pragma unroll
    for (int i = 0; i < 2; ++i) { int R, C; stage_rc(tid * 16 + i * 8192, R, C); const int Rb = Epi::PERM ? ((R & ~31) + perm32(R & 31)) : R;
        voffA[i] = (unsigned)(R * K + C) * 2u; voffB[i] = (unsigned)(Rb * K + C) * 2u; }
    const size_t kstep = (size_t)(BK * 2);
    const size_t hstep = (size_t)HALF * K * 2;
    const size_t tstep = 2 * hstep;
    const unsigned ldsw = (unsigned)wid * 1024u;
    const int aoff = lds_byte(wr * 64 + fr, fq * 8), boff = lds_byte(wc * 32 + fr, fq * 8);
#define PG8_SA(b, h) (((b) * 2 + (h)) * HTB)
#define PG8_SB(b, h) ((4 + (b) * 2 + (h)) * HTB)
#define PG8_STAGE(bufoff, gbase, voff) do { _Pragma("unroll") for (int _i = 0; _i < 2; ++_i) \
        __builtin_amdgcn_global_load_lds((const unsigned*)((const char*)(gbase) + (voff)[_i]), (PG8_LAS unsigned*)(lds + (bufoff) + ldsw + _i * 8192), 16, 0, 0); } while (0)
#define PG8_LDA(dst, b, h) do { _Pragma("unroll") for (int m = 0; m < 4; ++m) _Pragma("unroll") for (int k = 0; k < 2; ++k) dst[m][k] = *(const PG8_LAS bf16x8*)(lds + PG8_SA(b, h) + aoff + m * 2048 + k * 1024); } while (0)
#define PG8_LDB(dst, b, h) do { _Pragma("unroll") for (int n = 0; n < 2; ++n) _Pragma("unroll") for (int k = 0; k < 2; ++k) dst[n][k] = *(const PG8_LAS bf16x8*)(lds + PG8_SB(b, h) + boff + n * 2048 + k * 1024); } while (0)
#define PG8_MMA(ai, bj, At, Bt) do { __builtin_amdgcn_s_setprio(1); _Pragma("unroll") for (int m = 0; m < 4; ++m) _Pragma("unroll") for (int n = 0; n < 2; ++n) _Pragma("unroll") for (int k = 0; k < 2; ++k) \
        acc[ai][bj][m][n] = __builtin_amdgcn_mfma_f32_16x16x32_bf16(Bt[n][k], At[m][k], acc[ai][bj][m][n], 0, 0, 0); __builtin_amdgcn_s_setprio(0); } while (0)
#define PG8_WAIT_V(n) asm volatile("s_waitcnt vmcnt(" #n ")" ::: "memory")
#define PG8_WAIT_L(n) asm volatile("s_waitcnt lgkmcnt(" #n ")" ::: "memory")
#define PG8_BAR __builtin_amdgcn_s_barrier()
#define PG8_SCHED __builtin_amdgcn_sched_barrier(0)
    Unit cur, nxt; int ui = 0;
    if (!S.next(0, cur)) return;
    f32x4 acc[2][2][4][2];
#pragma unroll
    for (int a = 0; a < 2; ++a)
#pragma unroll
        for (int b = 0; b < 2; ++b)
#pragma unroll
            for (int m = 0; m < 4; ++m)
#pragma unroll
                for (int n = 0; n < 2; ++n) acc[a][b][m][n] = (f32x4){0.f, 0.f, 0.f, 0.f};
    bf16x8 At[4][2], B0[2][2], B1[2][2];
    const char* cA = (const char*)g.A + (size_t)cur.pm * tstep; const char* cB = (const char*)g.Bt + (size_t)cur.pn * tstep;
    S.a_ready(cur);
    if constexpr (SP2) {
        PG8_STAGE(PG8_SB(0, 0), cB, voffB); PG8_STAGE(PG8_SB(0, 1), cB + hstep, voffB); PG8_STAGE(PG8_SA(0, 0), cA, voffA); PG8_STAGE(PG8_SA(0, 1), cA + hstep, voffA);
        if (wr == 1) PG8_BAR;
        PG8_WAIT_V(2); PG8_BAR;
        PG8_STAGE(PG8_SB(1, 0), cB + kstep, voffB); PG8_STAGE(PG8_SA(1, 0), cA + kstep, voffA); PG8_STAGE(PG8_SB(1, 1), cB + hstep + kstep, voffB);
        PG8_WAIT_V(6); PG8_BAR;
    } else {
        PG8_STAGE(PG8_SB(0, 0), cB, voffB); PG8_STAGE(PG8_SA(0, 0), cA, voffA); PG8_STAGE(PG8_SB(0, 1), cB + hstep, voffB); PG8_STAGE(PG8_SA(0, 1), cA + hstep, voffA);
        if (wr == 1) PG8_BAR;
        PG8_WAIT_V(4); PG8_BAR;
        PG8_STAGE(PG8_SB(1, 0), cB + kstep, voffB); PG8_STAGE(PG8_SA(1, 0), cA + kstep, voffA); PG8_STAGE(PG8_SB(1, 1), cB + hstep + kstep, voffB);
        PG8_WAIT_V(6); PG8_BAR;
    }
    for (;;) {
        const bool has_next = S.next(ui + 1, nxt);
        const char* nA = has_next ? (const char*)g.A + (size_t)nxt.pm * tstep : cA; const char* nB = has_next ? (const char*)g.Bt + (size_t)nxt.pn * tstep : cB;
        for (int t = 0; t < nt; t += 2) {
            const bool last = (t == nt - 2);
            const char* a1 = cA + (size_t)(t + 1) * kstep;
            const char* a2 = last ? nA : cA + (size_t)(t + 2) * kstep; const char* b2 = last ? nB : cB + (size_t)(t + 2) * kstep;
            const char* a3 = a2 + kstep; const char* b3 = b2 + kstep;
            if (last && has_next) S.a_ready(nxt);
            if constexpr (SP2) {
            PG8_LDB(B0, 0, 0); PG8_LDB(B1, 0, 1); PG8_SCHED; PG8_LDA(At, 0, 0); PG8_STAGE(PG8_SA(1, 1), a1 + hstep, voffA);
            PG8_WAIT_V(8); PG8_WAIT_L(0); PG8_BAR; PG8_MMA(0, 0, At, B0); PG8_MMA(0, 1, At, B1); PG8_BAR; PG8_SCHED;
            PG8_LDA(At, 0, 1); PG8_STAGE(PG8_SB(0, 0), b2, voffB); PG8_STAGE(PG8_SB(0, 1), b2 + hstep, voffB); PG8_STAGE(PG8_SA(0, 0), a2, voffA);
            PG8_WAIT_V(8); PG8_WAIT_L(0); PG8_BAR; PG8_MMA(1, 0, At, B0); PG8_MMA(1, 1, At, B1); PG8_BAR; PG8_SCHED;
            PG8_LDB(B0, 1, 0); PG8_LDB(B1, 1, 1); PG8_SCHED; PG8_LDA(At, 1, 0); PG8_STAGE(PG8_SA(0, 1), a2 + hstep, voffA);
            PG8_WAIT_V(8); PG8_WAIT_L(0); PG8_BAR; PG8_MMA(0, 0, At, B0); PG8_MMA(0, 1, At, B1); PG8_BAR; PG8_SCHED;
            PG8_LDA(At, 1, 1); PG8_STAGE(PG8_SB(1, 0), b3, voffB); PG8_STAGE(PG8_SB(1, 1), b3 + hstep, voffB); PG8_STAGE(PG8_SA(1, 0), a3, voffA);
            PG8_WAIT_V(8); PG8_WAIT_L(0); PG8_BAR; PG8_MMA(1, 0, At, B0); PG8_MMA(1, 1, At, B1); PG8_BAR; PG8_SCHED;
            } else {
            PG8_LDB(B0, 0, 0); PG8_SCHED; PG8_LDA(At, 0, 0); PG8_STAGE(PG8_SA(1, 1), a1 + hstep, voffA);
            PG8_WAIT_L(8); PG8_BAR; PG8_WAIT_L(0); PG8_MMA(0, 0, At, B0); PG8_BAR; PG8_SCHED;
            PG8_LDB(B1, 0, 1); PG8_STAGE(PG8_SB(0, 0), b2, voffB);
            PG8_BAR; PG8_WAIT_L(0); PG8_MMA(0, 1, At, B1); PG8_BAR;
            PG8_LDA(At, 0, 1); PG8_STAGE(PG8_SA(0, 0), a2, voffA);
            PG8_BAR; PG8_WAIT_L(0); PG8_MMA(1, 0, At, B0); PG8_BAR; PG8_SCHED;
            PG8_STAGE(PG8_SB(0, 1), b2 + hstep, voffB);
            PG8_WAIT_V(6); PG8_BAR; PG8_MMA(1, 1, At, B1); PG8_BAR;
            PG8_LDB(B0, 1, 0); PG8_SCHED; PG8_LDA(At, 1, 0); PG8_STAGE(PG8_SA(0, 1), a2 + hstep, voffA);
            PG8_WAIT_L(8); PG8_BAR; PG8_WAIT_L(0); PG8_MMA(0, 0, At, B0); PG8_BAR; PG8_SCHED;
            PG8_LDB(B1, 1, 1); PG8_STAGE(PG8_SB(1, 0), b3, voffB);
            PG8_BAR; PG8_WAIT_L(0); PG8_MMA(0, 1, At, B1); PG8_BAR;
            PG8_LDA(At, 1, 1); PG8_STAGE(PG8_SA(1, 0), a3, voffA);
            PG8_BAR; PG8_WAIT_L(0); PG8_MMA(1, 0, At, B0); PG8_BAR; PG8_SCHED;
            PG8_STAGE(PG8_SB(1, 1), b3 + hstep, voffB);
            PG8_WAIT_V(6); PG8_BAR; PG8_MMA(1, 1, At, B1); PG8_BAR;
            }
        }
        if constexpr (ALIGN_EPI) { if (wr == 0) PG8_BAR; }
        if constexpr (!Epi::AFTER_DRAIN) { int fr_ = fr, fq_ = fq, wr_ = wr, wc_ = wc; asm volatile("" : "+v"(fr_), "+v"(fq_), "+s"(wr_), "+s"(wc_));
            E(acc, cur, wr_, wc_, fr_, fq_); S.done(cur); }
        if (!has_next) break;
#pragma unroll
        for (int a = 0; a < 2; ++a)
#pragma unroll
            for (int b = 0; b < 2; ++b)
#pragma unroll
                for (int m = 0; m < 4; ++m)
#pragma unroll
                    for (int n = 0; n < 2; ++n) acc[a][b][m][n] = (f32x4){0.f, 0.f, 0.f, 0.f};
        cur = nxt; cA = nA; cB = nB; ++ui;
        if constexpr (ALIGN_EPI) { if (wr == 1) PG8_BAR; }
    }
    PG8_WAIT_V(0);
    if constexpr (!ALIGN_EPI) { if (wr == 0) PG8_BAR; }
    PG8_BAR;
    if constexpr (Epi::AFTER_DRAIN) { E.fused(acc, cur, wr, wc, fr, fq, lds, wid, lane); S.done(cur); }
#undef PG8_SA
#undef PG8_SB
#undef PG8_STAGE
#undef PG8_LDA
#undef PG8_LDB
#undef PG8_MMA
#undef PG8_WAIT_V
#undef PG8_WAIT_L
#undef PG8_BAR
#undef PG8_SCHED
}
}

#ifndef PG8_SP2
#define PG8_SP2 true
#endif
#ifndef PG8_ALIGN
#define PG8_ALIGN true
#endif

constexpr int NWAVES = 8;
constexpr int DM = 1024, MP = 16384, MS = 128, MT = MP + MS, MPAD = 16640;
constexpr int NIN = 3328;
constexpr int DFF = 2816, DFF2 = 5632;
constexpr int NLAYER = 2;
constexpr int GLA_UNITS = 1024 + 128;
constexpr float EPS = 1e-6f;
constexpr size_t O_YP = 0, O_YS = 16777216, O_KP = 16908288, O_VP = 25296896, O_SGP = 33685504, O_CP = 33947648, O_KS = 34037760, O_VS = 34168832, O_SGS = 34299904, O_CS = 36397056, O_END = 37117952;

constexpr size_t MiB = 1u << 20;
constexpr size_t WS_CTL = 0, CTL_ZERO_BYTES = 1 * MiB;
constexpr size_t WS_WIN = 1 * MiB, WS_WOUT = 14 * MiB, WS_WUP = 18 * MiB, WS_WDN = 40 * MiB, WS_CSTAB = 51 * MiB, WS_RINV = 52 * MiB, WS_GL = 53 * MiB, WS_GDEC = 55 * MiB;
constexpr size_t WS_XB = 56 * MiB, WS_XRES = 89 * MiB, WS_QA = 154 * MiB, WS_KA = 171 * MiB, WS_VA = 188 * MiB, WS_QB = 205 * MiB, WS_KB = 214 * MiB, WS_VB = 223 * MiB, WS_RB = 240 * MiB;
constexpr size_t WS_BCUM = 257 * MiB, WS_UST = 274 * MiB, WS_SPREV = 310 * MiB, WS_MIX = 342 * MiB, WS_MBUF = 375 * MiB, WS_U = 440 * MiB, WS_Y = 619 * MiB, WS_OP = 709 * MiB, WS_LSE = 757 * MiB, WS_END = 759 * MiB;
static_assert(WS_WIN + (size_t)NLAYER * NIN * DM * 2 <= WS_WOUT && WS_WUP + (size_t)NLAYER * DFF2 * DM * 2 <= WS_WDN && WS_WDN + (size_t)NLAYER * DM * DFF * 2 <= WS_CSTAB, "ws map (weights)");
static_assert(WS_XB + (size_t)MPAD * DM * 2 <= WS_XRES && WS_XRES + (size_t)MT * DM * 4 <= WS_QA && WS_QA + (size_t)MT * 512 * 2 <= WS_KA && WS_QB + (size_t)MT * 256 * 2 <= WS_KB, "ws map (acts)");
static_assert(WS_BCUM + (size_t)MT * 256 * 4 <= WS_UST && WS_UST + (size_t)GLA_UNITS * 8192 * 4 <= WS_SPREV && WS_SPREV + (size_t)1024 * 8192 * 4 <= WS_MIX && WS_MIX + (size_t)MPAD * DM * 2 <= WS_MBUF, "ws map (gla)");
static_assert(WS_MBUF + (size_t)MT * DM * 4 <= WS_U && WS_U + (size_t)MPAD * DFF2 * 2 <= WS_Y && WS_Y + (size_t)MPAD * DFF * 2 <= WS_OP && WS_OP + (size_t)3 * MP * 512 * 2 <= WS_LSE && WS_LSE + (size_t)3 * MP * 8 * 4 <= WS_END, "ws map (ffn)");
static_assert(pg8::EP_CSTAB == WS_CSTAB && pg8::EP_RINV == WS_RINV && pg8::EP_GL == WS_GL && pg8::EP_QA == WS_QA && pg8::EP_KA == WS_KA && pg8::EP_VA == WS_VA && pg8::EP_QB == WS_QB && pg8::EP_KB == WS_KB && pg8::EP_VB == WS_VB && pg8::EP_RB == WS_RB && pg8::EP_U == WS_U, "epilogue ws offsets");
static_assert(pg8::EP_O_KP == O_KP && pg8::EP_O_VP == O_VP && pg8::EP_O_CP == O_CP && pg8::EP_O_KS == O_KS && pg8::EP_O_VS == O_VS && pg8::EP_O_CS == O_CS, "epilogue out offsets");
constexpr int CW_BAR = 4096;

constexpr int RING_OFF = 0, RING_BYTES = 131072;
constexpr int LDSCTL_OFF = RING_BYTES, MISC_OFF = LDSCTL_OFF + 320;
constexpr int LDS_BYTES = 147456;
static_assert(MISC_OFF + 128 <= LDS_BYTES, "LDS map");

#define GAS __attribute__((address_space(1)))
#define LAS __attribute__((address_space(3)))
typedef unsigned short bf16;
typedef unsigned v4u __attribute__((ext_vector_type(4)));
typedef float f32x4 __attribute__((ext_vector_type(4)));
typedef GAS unsigned gu32;
#define RLX_AGENT __ATOMIC_RELAXED, __HIP_MEMORY_SCOPE_AGENT
#define LDS_WAIT() asm volatile("s_waitcnt lgkmcnt(0)" ::: "memory")
#define VM_WAIT() asm volatile("s_waitcnt vmcnt(0)" ::: "memory")
__device__ __forceinline__ unsigned f2bf(float f) { unsigned u = __builtin_bit_cast(unsigned, f); return (u + 0x7fffu + ((u >> 16) & 1u)) >> 16; }
__device__ __forceinline__ unsigned pk2(float lo, float hi) { return f2bf(lo) | (f2bf(hi) << 16); }
__device__ __forceinline__ float bf2f(unsigned short b) { return __builtin_bit_cast(float, (unsigned)b << 16); }
__device__ __forceinline__ float bflo(unsigned w) { return __builtin_bit_cast(float, w << 16); }
__device__ __forceinline__ float bfhi(unsigned w) { return __builtin_bit_cast(float, w & 0xffff0000u); }
__device__ __forceinline__ float wave_sum(float v) {
#pragma unroll
    for (int o = 1; o < 64; o <<= 1) v += __shfl_xor(v, o);
    return v;
}
__device__ __forceinline__ float wave_max(float v) {
#pragma unroll
    for (int o = 1; o < 64; o <<= 1) v = fmaxf(v, __shfl_xor(v, o));
    return v;
}
#define XB_TMO      128
#define XB_XCNT(j)  (256  + 64 * (j))
#define XB_XSUB(j)  (1280 + 64 * (j))
#define XB_XGEN(j)  (2304 + 64 * (j))
#define XB_TOP      3328
#define XB_TOPGEN   3392
#define XCD_BAR_WORDS 3456
#define XB_SPIN_CAP (1u << 18)

__device__ __forceinline__ unsigned xb_ld(unsigned* p)              { return __hip_atomic_load(p, __ATOMIC_RELAXED, __HIP_MEMORY_SCOPE_AGENT); }
__device__ __forceinline__ unsigned xb_add(unsigned* p, unsigned v) { return __hip_atomic_fetch_add(p, v, __ATOMIC_RELAXED, __HIP_MEMORY_SCOPE_AGENT); }
__device__ __forceinline__ unsigned xb_xcc_id() { return (unsigned)__builtin_amdgcn_s_getreg((3 << 11) | 20) & 0xFu; }
#define XB_SPIN(cond, bar) do { unsigned _sp = 0; while (cond) { __builtin_amdgcn_s_sleep(1); \
    if ((++_sp & 255u) == 0u) { if (xb_ld(&(bar)[XB_TMO])) break; if (_sp > XB_SPIN_CAP) { atomicAdd(&(bar)[XB_TMO], 1u); break; } } } } while (0)

struct XcdBarrier {
    unsigned* bar; unsigned x;
    volatile LAS unsigned* st;
};

__device__ __forceinline__ XcdBarrier xcd_barrier_post(unsigned* bar, volatile LAS unsigned* st) {
    XcdBarrier b; b.bar = bar; b.x = xb_xcc_id(); b.st = st;
    if (threadIdx.x == 0) (void)xb_add(&bar[XB_XCNT(b.x)], 1u);
    return b;
}
__device__ __forceinline__ void xcd_barrier_complete(unsigned* bar, unsigned x, unsigned& nloc, unsigned& nx) {
    const unsigned G = gridDim.x * gridDim.y * gridDim.z;
    unsigned sum, cnt, mine, sp = 0u;
    for (;;) {
        sum = 0u; cnt = 0u; mine = 0u;
#pragma unroll
        for (unsigned j = 0; j < 16; ++j) { const unsigned c = xb_ld(&bar[XB_XCNT(j)]); sum += c; cnt += (c > 0u) ? 1u : 0u; mine = (j == x) ? c : mine; }
        if (sum == G) break;
        __builtin_amdgcn_s_sleep(1);
        if ((++sp & 255u) == 0u) { if (xb_ld(&bar[XB_TMO])) break; if (sp > XB_SPIN_CAP) { atomicAdd(&bar[XB_TMO], 1u); break; } }
    }
    nloc = mine > 0u ? mine : 1u; nx = cnt > 0u ? cnt : 1u;
}

__device__ __forceinline__ void xcd_barrier(const XcdBarrier& b) {
    asm volatile("s_waitcnt vmcnt(0)" ::: "memory");
    __syncthreads();
    if (threadIdx.x == 0) {
        unsigned* bar = b.bar;
        __builtin_amdgcn_s_waitcnt(0);
        unsigned nloc = b.st[0], nx = b.st[1];
        if (nloc == 0u) { xcd_barrier_complete(bar, b.x, nloc, nx); b.st[0] = nloc; b.st[1] = nx; }
        const unsigned old = xb_add(&bar[XB_XSUB(b.x)], 1u);
        const unsigned gen = old / nloc;
        if (old + 1u == (gen + 1u) * nloc) {
            __builtin_amdgcn_fence(__ATOMIC_RELEASE, "agent");
            asm volatile("s_waitcnt vmcnt(0)" ::: "memory");
            const unsigned og = xb_add(&bar[XB_TOP], 1u);
            const unsigned tg = og / nx;
            if (og + 1u == (tg + 1u) * nx) xb_add(&bar[XB_TOPGEN], 1u);
            else XB_SPIN(xb_ld(&bar[XB_TOPGEN]) == tg, bar);
            __builtin_amdgcn_fence(__ATOMIC_ACQUIRE, "agent");
            xb_add(&bar[XB_XGEN(b.x)], 1u);
            asm volatile("s_waitcnt vmcnt(0)" ::: "memory");
        } else {
            XB_SPIN(xb_ld(&bar[XB_XGEN(b.x)]) == gen, bar);
            __builtin_amdgcn_fence(__ATOMIC_ACQUIRE, "agent");
            asm volatile("s_waitcnt vmcnt(0)" ::: "memory");
        }
    }
    __syncthreads();
}

struct Args { const float* in[19]; float* out; unsigned char* ws; float inv_freq[8]; int ph_lo, ph_hi, li, pad; };
enum { I_XP = 0, I_XS, I_CK, I_CV, I_SG, I_SC, I_GMPRE, I_GMPOST, I_GFPRE, I_GFPOST, I_WIN, I_WG2, I_BG, I_GGLA, I_WOUT, I_WUP, I_CW, I_CB, I_WDN };
#define WSP(T, off) ((T*)(ws + (off)))

constexpr int PTAB_OFF = LDSCTL_OFF + 1024;
__device__ __forceinline__ const float* inptr(LAS unsigned char* lds, int k) {
    const unsigned long long v = ((const LAS unsigned long long*)(lds + PTAB_OFF))[k];
    const unsigned lo = __builtin_amdgcn_readfirstlane((unsigned)v), hi = __builtin_amdgcn_readfirstlane((unsigned)(v >> 32));
    return (const float*)(((unsigned long long)hi << 32) | lo);
}
#define INP(k) inptr(lds, (k))

__device__ __forceinline__ void tr_item(const float* W, int K, int N, const float* g, bf16* WT, LAS float* scr, int item, int nblk, int lane) {
    const int kb = item / nblk, nb = item % nblk, k0 = 64 * kb, n0 = 32 * nb;
#pragma unroll 8
    for (int i = 0; i < 32; ++i) { const int kk = 2 * i + (lane >> 5), n = n0 + (lane & 31);
        float v = (n < N) ? W[(size_t)(k0 + kk) * N + n] : 0.f; if (g) v *= g[k0 + kk]; scr[kk * 33 + (lane & 31)] = v; }
    LDS_WAIT(); asm volatile("" ::: "memory");
    const int c = lane & 7;
#pragma unroll
    for (int j = 0; j < 4; ++j) { const int n = (lane >> 3) + 8 * j; const LAS float* s = scr + (8 * c) * 33 + n;
        v4u o; o.x = pk2(s[0 * 33], s[1 * 33]); o.y = pk2(s[2 * 33], s[3 * 33]); o.z = pk2(s[4 * 33], s[5 * 33]); o.w = pk2(s[6 * 33], s[7 * 33]);
        *(GAS v4u*)(WT + (size_t)(n0 + n) * K + k0 + 8 * c) = o; }
    LDS_WAIT(); asm volatile("" ::: "memory");
}
__device__ __forceinline__ void x_row_prep(const float* xr, bf16* xb, float* rinv, int lane) {
    const GAS f32x4* x4 = (const GAS f32x4*)xr + lane;
    f32x4 v[4]; float ss = 0.f;
#pragma unroll
    for (int j = 0; j < 4; ++j) { v[j] = x4[64 * j]; ss += (v[j].x * v[j].x + v[j].y * v[j].y) + (v[j].z * v[j].z + v[j].w * v[j].w); }
    ss = wave_sum(ss);
    if (lane == 0) *rinv = 1.0f / sqrtf(ss * (1.0f / 1024.0f) + EPS);
    GAS unsigned long long* o8 = (GAS unsigned long long*)xb + lane;
#pragma unroll
    for (int j = 0; j < 4; ++j) o8[64 * j] = (unsigned long long)pk2(v[j].x, v[j].y) | ((unsigned long long)pk2(v[j].z, v[j].w) << 32);
}
__device__ __forceinline__ void phase_prologue(const Args& args, unsigned char* ws, LAS unsigned char* lds, int vcu, int G, int wave, int lane, int tid) {
    LAS float* scr = (LAS float*)(lds + wave * 16384);
    const int gw = vcu * NWAVES + wave, NGW = G * NWAVES;
    constexpr int I_IN = 16 * 97, I_OUT = 16 * 32, I_UP = 16 * 176, I_DN = 44 * 32, I_L = I_IN + I_OUT + I_UP + I_DN;
    for (int it = gw; it < NLAYER * I_L; it += NGW) {
        const int l = it / I_L; int r = it % I_L;
        if (r < I_IN) { tr_item(INP(I_WIN) + (size_t)l * 1024 * 3088, 1024, 3088, INP(I_GMPRE) + l * 1024, WSP(bf16, WS_WIN) + (size_t)l * NIN * 1024, scr, r, 97, lane); continue; }
        r -= I_IN;
        if (r < I_OUT) { tr_item(INP(I_WOUT) + (size_t)l * 1024 * 1024, 1024, 1024, nullptr, WSP(bf16, WS_WOUT) + (size_t)l * 1024 * 1024, scr, r, 32, lane); continue; }
        r -= I_OUT;
        if (r < I_UP) { tr_item(INP(I_WUP) + (size_t)l * 1024 * DFF2, 1024, DFF2, INP(I_GFPRE) + l * 1024, WSP(bf16, WS_WUP) + (size_t)l * DFF2 * 1024, scr, r, 176, lane); continue; }
        r -= I_UP;
        tr_item(INP(I_WDN) + (size_t)l * DFF * 1024, DFF, 1024, nullptr, WSP(bf16, WS_WDN) + (size_t)l * 1024 * DFF, scr, r, 32, lane);
    }
    const int gt = vcu * (NWAVES * 64) + tid, NGT = G * NWAVES * 64;
    for (int i = gt; i < NLAYER * 28672; i += NGT) { const int l = i / 28672, r = i % 28672; ((GAS v4u*)(ws + WS_WIN + (size_t)l * NIN * 2048 + (size_t)3104 * 2048))[r] = (v4u){0u, 0u, 0u, 0u}; }
    for (int i = gt; i < 16384; i += NGT) ((GAS v4u*)(ws + WS_MIX + (size_t)MT * 2048))[i] = (v4u){0u, 0u, 0u, 0u};
    for (int i = gt; i < 45056; i += NGT) ((GAS v4u*)(ws + WS_Y + (size_t)MT * DFF * 2))[i] = (v4u){0u, 0u, 0u, 0u};
    for (int i = gt; i < 4100 * 8; i += NGT) { const int p = i >> 3, d = i & 7; const int pos = p < 4096 ? p : 16384 + (p - 4096);
        const float f = ((const LAS float*)(lds + PTAB_OFF + 256))[d];
        const float ang = (float)pos * f;
        double rev = (double)ang * 0.15915494309189535; rev -= floor(rev);
        const float fr_ = (float)rev;
        WSP(float, WS_CSTAB)[2 * i] = __builtin_amdgcn_cosf(fr_); WSP(float, WS_CSTAB)[2 * i + 1] = __builtin_amdgcn_sinf(fr_); }
    for (int row = gw; row < MPAD; row += NGW) {
        bf16* xb = WSP(bf16, WS_XB) + (size_t)row * 1024; float* ri = WSP(float, WS_RINV) + row;
        if (row >= MT) { GAS unsigned long long* o8 = (GAS unsigned long long*)xb + lane;
#pragma unroll
            for (int j = 0; j < 4; ++j) o8[64 * j] = 0ull;
            if (lane == 0) *ri = 0.f; continue; }
        const float* xr = row < MP ? INP(I_XP) + (size_t)row * 1024 : INP(I_XS) + (size_t)(row - MP) * 1024;
        x_row_prep(xr, xb, ri, lane);
    }
}

#define UNPK8(dst, o_, W_) do { dst[(o_) + 0] = bflo((W_).x); dst[(o_) + 1] = bfhi((W_).x); dst[(o_) + 2] = bflo((W_).y); dst[(o_) + 3] = bfhi((W_).y); \
                                dst[(o_) + 4] = bflo((W_).z); dst[(o_) + 5] = bfhi((W_).z); dst[(o_) + 6] = bflo((W_).w); dst[(o_) + 7] = bfhi((W_).w); } while (0)
namespace att {
typedef short bf16x8 __attribute__((ext_vector_type(8)));
typedef short s16x4 __attribute__((ext_vector_type(4)));
typedef float f32x16 __attribute__((ext_vector_type(16)));
typedef float f32x2_t __attribute__((ext_vector_type(2))); typedef __bf16 bf16x2_t __attribute__((ext_vector_type(2)));
constexpr float NEG = -1e30f;
__device__ __forceinline__ int crow(int r, int hi) { return (r & 3) + 8 * (r >> 2) + 4 * hi; }
__device__ __forceinline__ unsigned cvtpk(float lo, float hi) { f32x2_t v = {lo, hi}; bf16x2_t b = __builtin_convertvector(v, bf16x2_t); return __builtin_bit_cast(unsigned, b); }
__device__ __forceinline__ s16x4 vtr(const LAS unsigned char* p) { return __builtin_bit_cast(s16x4, __builtin_amdgcn_ds_read_tr16_b64_v4i16((LAS s16x4*)p)); }
__device__ __forceinline__ void step(const LAS unsigned char* Kt, const LAS unsigned char* Vt, const bf16x8 (&qf)[4], float& m, float& l, f32x16& o0, f32x16& o1, int kn0, int nq, bool need_mask, int lane) {
    const int r32 = lane & 31, hi = lane >> 5, sw = (r32 >> 1) & 7;
    f32x16 s;
#pragma unroll
    for (int r = 0; r < 16; ++r) s[r] = 0.f;
#pragma unroll
    for (int st = 0; st < 4; ++st) { const bf16x8 kf = *(const LAS bf16x8*)(Kt + r32 * 128 + (((2 * st + hi) ^ sw) << 4)); s = __builtin_amdgcn_mfma_f32_32x32x16_bf16(kf, qf[st], s, 0, 0, 0); }
    if (need_mask) {
#pragma unroll
        for (int r = 0; r < 16; ++r) { const int kn = kn0 + crow(r, hi), df = nq - kn; s[r] = (kn >= 0 && df >= 0 && df <= 128) ? s[r] : NEG; }
    }
    float mx = s[0];
#pragma unroll
    for (int r = 1; r < 16; ++r) mx = fmaxf(mx, s[r]);
    mx = fmaxf(mx, __shfl_xor(mx, 32));
    const float mn = fmaxf(m, mx), alpha = __builtin_amdgcn_exp2f(m - mn);
    float ps = 0.f;
#pragma unroll
    for (int r = 0; r < 16; ++r) { s[r] = __builtin_amdgcn_exp2f(s[r] - mn); ps += s[r]; }
    ps += __shfl_xor(ps, 32);
    l = l * alpha + ps; m = mn;
#pragma unroll
    for (int r = 0; r < 16; ++r) { o0[r] *= alpha; o1[r] *= alpha; }
    v4u pw0, pw1;
    pw0.x = cvtpk(s[0], s[1]); pw0.y = cvtpk(s[2], s[3]); pw0.z = cvtpk(s[4], s[5]); pw0.w = cvtpk(s[6], s[7]);
    pw1.x = cvtpk(s[8], s[9]); pw1.y = cvtpk(s[10], s[11]); pw1.z = cvtpk(s[12], s[13]); pw1.w = cvtpk(s[14], s[15]);
    const bf16x8 pf0 = __builtin_bit_cast(bf16x8, pw0), pf1 = __builtin_bit_cast(bf16x8, pw1);
    const LAS unsigned char* vb = Vt + ((lane >> 4) & 1) * 32 + (lane & 3) * 8 + (4 * hi + ((lane & 15) >> 2)) * 64;
#pragma unroll
    for (int d0 = 0; d0 < 2; ++d0)
#pragma unroll
        for (int s2 = 0; s2 < 2; ++s2) { const s16x4 lo = vtr(vb + d0 * 2048 + s2 * 1024), hh = vtr(vb + d0 * 2048 + s2 * 1024 + 512);
            const bf16x8 vf = (bf16x8){lo[0], lo[1], lo[2], lo[3], hh[0], hh[1], hh[2], hh[3]};
            if (d0 == 0) o0 = __builtin_amdgcn_mfma_f32_32x32x16_bf16(vf, s2 == 0 ? pf0 : pf1, o0, 0, 0, 0);
            else         o1 = __builtin_amdgcn_mfma_f32_32x32x16_bf16(vf, s2 == 0 ? pf0 : pf1, o1, 0, 0, 0); }
}
}

__device__ __forceinline__ void attn_unit_prompt(unsigned char* ws, LAS unsigned char* lds, int unit, int tid) {
    const int lane = tid & 63, w = __builtin_amdgcn_readfirstlane(tid >> 6), r32 = lane & 31, hi = lane >> 5;
    const int bh = unit / 48, u48 = unit - bh * 48, b = bh >> 3, h = bh & 7, p = u48 >> 4, w16 = u48 & 15, d = 1 << (2 * p), nsp = 16 >> (2 * p), r = w16 / nsp, sp = w16 - r * nsp;
    const int N0 = 256 * sp, rowbase = b * 4096 + r;
    const bf16* QA = WSP(bf16, WS_QA); const bf16* KA = WSP(bf16, WS_KA); const bf16* VA = WSP(bf16, WS_VA);
    LAS unsigned char* Kimg = lds; LAS unsigned char* Vimg = lds + 49152;
    for (int blk = w; blk < 48; blk += NWAVES) { const int T = blk >> 2, i = blk & 3;
        { const int key = 8 * i + (lane >> 3); int kn = N0 - 128 + 32 * T + key; kn = kn < 0 ? 0 : kn; const int c = (lane & 7) ^ ((key >> 1) & 7);
          __builtin_amdgcn_global_load_lds((const unsigned*)(KA + (size_t)(rowbase + d * kn) * 512 + h * 64 + 8 * c), (LAS unsigned*)(Kimg + T * 4096 + i * 1024), 16, 0, 0); }
        { const int d0 = i >> 1, s2 = i & 1; const int key = 16 * s2 + (lane >> 2); int kn = N0 - 128 + 32 * T + key; kn = kn < 0 ? 0 : kn;
          __builtin_amdgcn_global_load_lds((const unsigned*)(VA + (size_t)(rowbase + d * kn) * 512 + h * 64 + 32 * d0 + 8 * (lane & 3)), (LAS unsigned*)(Vimg + T * 4096 + d0 * 2048 + s2 * 1024), 16, 0, 0); } }
    const int nq = N0 + 32 * w + r32; const size_t qrow = (size_t)(rowbase + d * nq);
    att::bf16x8 qf[4];
#pragma unroll
    for (int st = 0; st < 4; ++st) qf[st] = *(const GAS att::bf16x8*)(QA + qrow * 512 + h * 64 + 16 * st + 8 * hi);
    asm volatile("s_waitcnt vmcnt(0)" ::: "memory"); __syncthreads();
    float m = att::NEG, l = 0.f; att::f32x16 o0, o1;
#pragma unroll
    for (int q = 0; q < 16; ++q) { o0[q] = 0.f; o1[q] = 0.f; }
#pragma unroll 1
    for (int j = 0; j < 5; ++j) { const int T = w + j, kn0 = N0 - 128 + 32 * T;
        if (kn0 + 31 < 0) continue;
        att::step(Kimg + T * 4096, Vimg + T * 4096, qf, m, l, o0, o1, kn0, nq, (j == 0) || (j == 4) || (kn0 < 0), lane); }
    const float il = 1.0f / l;
    bf16* op = WSP(bf16, WS_OP) + ((size_t)p * MP + qrow) * 512 + h * 64 + 4 * hi;
#pragma unroll
    for (int g = 0; g < 4; ++g) {
        *(GAS unsigned long long*)(op + 8 * g)      = (unsigned long long)att::cvtpk(o0[4 * g] * il, o0[4 * g + 1] * il) | ((unsigned long long)att::cvtpk(o0[4 * g + 2] * il, o0[4 * g + 3] * il) << 32);
        *(GAS unsigned long long*)(op + 32 + 8 * g) = (unsigned long long)att::cvtpk(o1[4 * g] * il, o1[4 * g + 1] * il) | ((unsigned long long)att::cvtpk(o1[4 * g + 2] * il, o1[4 * g + 3] * il) << 32); }
    if (hi == 0) WSP(float, WS_LSE)[((size_t)p * MP + qrow) * 8 + h] = m + __log2f(l);
    __syncthreads();
}
__device__ __forceinline__ void att_combine(unsigned char* ws, int vcu, int G, int tid) {
    const int gt = vcu * (NWAVES * 64) + tid, NGT = G * NWAVES * 64;
    const bf16* OP = WSP(bf16, WS_OP); const float* LSE = WSP(float, WS_LSE);
    for (int it = gt; it < MP * 64; it += NGT) { const int row = it >> 6, c8 = (it & 63) * 8, h = c8 >> 6;
        const float L0 = LSE[(size_t)row * 8 + h], L1 = LSE[((size_t)MP + row) * 8 + h], L2 = LSE[((size_t)2 * MP + row) * 8 + h];
        const float mx = fmaxf(L0, fmaxf(L1, L2)); float w0 = __builtin_amdgcn_exp2f(L0 - mx), w1 = __builtin_amdgcn_exp2f(L1 - mx), w2 = __builtin_amdgcn_exp2f(L2 - mx);
        const float inv = 1.0f / (w0 + w1 + w2); w0 *= inv; w1 *= inv; w2 *= inv;
        const v4u a = *(const GAS v4u*)(OP + (size_t)row * 512 + c8), bq = *(const GAS v4u*)(OP + ((size_t)MP + row) * 512 + c8), cq = *(const GAS v4u*)(OP + ((size_t)2 * MP + row) * 512 + c8);
        float fa[8], fb[8], fc[8]; UNPK8(fa, 0, a); UNPK8(fb, 0, bq); UNPK8(fc, 0, cq);
        unsigned o[4];
#pragma unroll
        for (int i = 0; i < 8; i += 2) o[i >> 1] = pk2(w0 * fa[i] + w1 * fb[i] + w2 * fc[i], w0 * fa[i + 1] + w1 * fb[i + 1] + w2 * fc[i + 1]);
        *(GAS v4u*)(WSP(bf16, WS_MIX) + (size_t)row * 1024 + c8) = (v4u){o[0], o[1], o[2], o[3]}; }
}

__device__ __forceinline__ float dot_bf16_row(const float (&q)[64], const bf16* kp) {
    const GAS v4u* k4 = (const GAS v4u*)kp; float s = 0.f;
#pragma unroll
    for (int i = 0; i < 8; ++i) { const v4u w = k4[i];
        s += q[8 * i + 0] * bflo(w.x) + q[8 * i + 1] * bfhi(w.x) + q[8 * i + 2] * bflo(w.y) + q[8 * i + 3] * bfhi(w.y)
           + q[8 * i + 4] * bflo(w.z) + q[8 * i + 5] * bfhi(w.z) + q[8 * i + 6] * bflo(w.w) + q[8 * i + 7] * bfhi(w.w); }
    return s;
}
__device__ __forceinline__ float dot_f32_row(const float (&q)[64], const float* kp) {
    const GAS f32x4* k4 = (const GAS f32x4*)kp; float s = 0.f;
#pragma unroll
    for (int i = 0; i < 16; ++i) { const f32x4 w = k4[i]; s += q[4 * i] * w.x + q[4 * i + 1] * w.y + q[4 * i + 2] * w.z + q[4 * i + 3] * w.w; }
    return s;
}
__device__ __forceinline__ void attn_item_sample(unsigned char* ws, const float* ck, const float* cv, int l, int row, int h, LAS float* pbuf, int lane) {
    const bf16* QA = WSP(bf16, WS_QA); const bf16* KA = WSP(bf16, WS_KA); const bf16* VA = WSP(bf16, WS_VA);
    float q[64];
    { const GAS v4u* qp = (const GAS v4u*)(QA + (size_t)row * 512 + h * 64);
#pragma unroll
      for (int i = 0; i < 8; ++i) { const v4u w = qp[i]; UNPK8(q, 8 * i, w); } }
    const int sb = (row - MP) >> 2, si = (row - MP) & 3;
    const size_t cbase = (((size_t)l * 32 + sb) * 2048) * 512 + h * 64;
    float mx = -INFINITY;
#pragma unroll 1
    for (int it = 0; it < 7; ++it) {
        const int e = lane + 64 * it; const int ec = e < 387 ? e : 386;
        const int p = ec >= 258 ? 2 : (ec >= 129 ? 1 : 0); const int j = ec - 129 * p; const int dil = 1 << (2 * p);
        const int idx = 2048 + si - dil * j; float s;
        if (idx >= 2048) s = dot_bf16_row(q, KA + (size_t)(MP + sb * 4 + (idx - 2048)) * 512 + h * 64);
        else s = dot_f32_row(q, ck + cbase + (size_t)idx * 512);
        s = e < 387 ? s : -INFINITY; pbuf[e] = s; mx = fmaxf(mx, s);
    }
    mx = wave_max(mx);
    float ls = 0.f;
#pragma unroll
    for (int it = 0; it < 7; ++it) { const float pe = __builtin_amdgcn_exp2f(pbuf[lane + 64 * it] - mx); ls += pe; pbuf[lane + 64 * it] = pe; }
    ls = wave_sum(ls);
    LDS_WAIT(); asm volatile("" ::: "memory");
    const int g = lane >> 3, c = lane & 7;
    float acc[8];
#pragma unroll
    for (int i = 0; i < 8; ++i) acc[i] = 0.f;
#pragma unroll 7
    for (int e = g; e < 387; e += 8) {
        const int p = e >= 258 ? 2 : (e >= 129 ? 1 : 0); const int j = e - 129 * p; const int dil = 1 << (2 * p);
        const int idx = 2048 + si - dil * j; const float pe = pbuf[e]; float v[8];
        if (idx >= 2048) { const v4u w = *(const GAS v4u*)(VA + (size_t)(MP + sb * 4 + (idx - 2048)) * 512 + h * 64 + 8 * c); UNPK8(v, 0, w); }
        else { const GAS f32x4* vp = (const GAS f32x4*)(cv + cbase + (size_t)idx * 512 + 8 * c); const f32x4 a = vp[0], bq = vp[1]; v[0] = a.x; v[1] = a.y; v[2] = a.z; v[3] = a.w; v[4] = bq.x; v[5] = bq.y; v[6] = bq.z; v[7] = bq.w; }
#pragma unroll
        for (int i = 0; i < 8; ++i) acc[i] += pe * v[i];
    }
#pragma unroll
    for (int i = 0; i < 8; ++i) { acc[i] += __shfl_xor(acc[i], 8); acc[i] += __shfl_xor(acc[i], 16); acc[i] += __shfl_xor(acc[i], 32); }
    if (g == 0) { const float il = 1.0f / ls;
        *(GAS v4u*)(WSP(bf16, WS_MIX) + (size_t)row * 1024 + h * 64 + 8 * c) = (v4u){pk2(acc[0] * il, acc[1] * il), pk2(acc[2] * il, acc[3] * il), pk2(acc[4] * il, acc[5] * il), pk2(acc[6] * il, acc[7] * il)}; }
    LDS_WAIT(); asm volatile("" ::: "memory");
}

__device__ __forceinline__ void gla_unit_geom(int u, int& R0, int& c, int& h) {
    if (u < 1024) { const int bh = u >> 6, n = u & 63; h = bh & 3; R0 = (bh >> 2) * 4096 + n * 64; c = 64; }
    else { const int s = u - 1024; h = s & 3; R0 = MP + (s >> 2) * 4; c = 4; }
}
__device__ __forceinline__ void gla_local_unit(const Args& args, unsigned char* ws, LAS unsigned char* lds, int l, int u, int tid) {
    LAS float* sB = (LAS float*)lds; LAS float* sK = (LAS float*)(lds + 16384); LAS float* sV = (LAS float*)(lds + 32768);
    int R0, c, h; gla_unit_geom(u, R0, c, h);
    const float* GL = WSP(float, WS_GL); const float* wg2 = INP(I_WG2) + (size_t)l * 16 * 256; const float* bg = INP(I_BG) + l * 256;
    for (int idx = tid; idx < c * 64; idx += NWAVES * 64) { const int t = idx >> 6, kk = idx & 63; const float* gl = GL + (size_t)(R0 + t) * 16;
        float z = bg[h * 64 + kk];
#pragma unroll
        for (int r = 0; r < 16; ++r) z += gl[r] * wg2[r * 256 + h * 64 + kk];
        const float ls = fminf(z, 0.f) - __logf(1.0f + __expf(-fabsf(z)));
        sB[idx] = ls * (1.0f / 16.0f); }
    __syncthreads();
    if (tid < 64) { float a = 0.f; for (int t = 0; t < c; ++t) { a += sB[t * 64 + tid]; sB[t * 64 + tid] = a; } }
    __syncthreads();
    for (int idx = tid; idx < c * 64; idx += NWAVES * 64) { const int t = idx >> 6, kk = idx & 63; const float bb = sB[idx];
        WSP(float, WS_BCUM)[(size_t)(R0 + t) * 256 + h * 64 + kk] = bb;
        sK[idx] = bf2f(WSP(bf16, WS_KB)[(size_t)(R0 + t) * 256 + h * 64 + kk]) * __expf(sB[(c - 1) * 64 + kk] - bb); }
    for (int idx = tid; idx < c * 128; idx += NWAVES * 64) { const int t = idx >> 7, vv = idx & 127; sV[idx] = bf2f(WSP(bf16, WS_VB)[(size_t)(R0 + t) * 512 + h * 128 + vv]); }
    if (tid < 64) WSP(float, WS_GDEC)[u * 64 + tid] = __expf(sB[(c - 1) * 64 + tid]);
    __syncthreads();
    { const int kk = tid >> 3, v0 = (tid & 7) * 16; float acc[16];
#pragma unroll
      for (int i = 0; i < 16; ++i) acc[i] = 0.f;
      for (int s = 0; s < c; ++s) { const float kv = sK[s * 64 + kk];
#pragma unroll
          for (int i = 0; i < 16; ++i) acc[i] += kv * sV[s * 128 + v0 + i]; }
      GAS f32x4* up = (GAS f32x4*)(WSP(float, WS_UST) + (size_t)u * 8192 + kk * 128 + v0);
#pragma unroll
      for (int i = 0; i < 4; ++i) up[i] = (f32x4){acc[4 * i], acc[4 * i + 1], acc[4 * i + 2], acc[4 * i + 3]}; }
    __syncthreads();
}

__device__ __forceinline__ void gla_scan(const Args& args, unsigned char* ws, LAS unsigned char* lds, int l, int vcu, int G, int tid) {
    const int gt = vcu * (NWAVES * 64) + tid, NGT = G * NWAVES * 64;
    const float* UST = WSP(float, WS_UST); const float* GDEC = WSP(float, WS_GDEC); float* SPREV = WSP(float, WS_SPREV);
    for (int g = gt; g < 16 * 8192; g += NGT) { const int sh = g >> 13, e = g & 8191, kk = e >> 7; float S = 0.f;
#pragma unroll 8
        for (int n = 0; n < 64; ++n) { const int u = sh * 64 + n; SPREV[(size_t)u * 8192 + e] = S; S = GDEC[u * 64 + kk] * S + UST[(size_t)u * 8192 + e]; }
        args.out[O_SGP + ((size_t)l * 16 + sh) * 8192 + e] = S; }
    for (int g = gt; g < 128 * 8192; g += NGT) { const int shs = g >> 13, e = g & 8191, kk = e >> 7, u = 1024 + shs;
        const float S0 = INP(I_SG)[((size_t)l * 128 + shs) * 8192 + e];
        args.out[O_SGS + ((size_t)l * 128 + shs) * 8192 + e] = GDEC[u * 64 + kk] * S0 + UST[(size_t)u * 8192 + e]; }
}

__device__ __forceinline__ void gla_out_unit(const Args& args, unsigned char* ws, LAS unsigned char* lds, int l, int u, int tid) {
    LAS float* sQ = (LAS float*)lds; LAS float* sK = (LAS float*)(lds + 16384); LAS float* sV = (LAS float*)(lds + 32768); LAS float* sS = (LAS float*)(lds + 65536); LAS float* sA = (LAS float*)(lds + 98304);
    int R0, c, h; gla_unit_geom(u, R0, c, h);
    for (int idx = tid; idx < c * 64; idx += NWAVES * 64) { const int t = idx >> 6, kk = idx & 63; const size_t off = (size_t)(R0 + t) * 256 + h * 64 + kk;
        const float bb = WSP(float, WS_BCUM)[off];
        sQ[idx] = bf2f(WSP(bf16, WS_QB)[off]) * __expf(bb); sK[idx] = bf2f(WSP(bf16, WS_KB)[off]) * __expf(-bb); }
    for (int idx = tid; idx < c * 128; idx += NWAVES * 64) { const int t = idx >> 7, vv = idx & 127; sV[idx] = bf2f(WSP(bf16, WS_VB)[(size_t)(R0 + t) * 512 + h * 128 + vv]); }
    { const float* sp = u < 1024 ? WSP(float, WS_SPREV) + (size_t)u * 8192 : INP(I_SG) + ((size_t)l * 128 + (u - 1024)) * 8192;
      for (int idx = tid; idx < 8192; idx += NWAVES * 64) sS[idx] = sp[idx]; }
    __syncthreads();
    for (int idx = tid; idx < c * c; idx += NWAVES * 64) { const int t = idx / c, s = idx - t * c; float a = 0.f;
        if (s <= t) { for (int kk = 0; kk < 64; ++kk) a += sQ[t * 64 + kk] * sK[s * 64 + kk]; }
        sA[t * 64 + s] = a; }
    __syncthreads();
    { const int t = tid >> 3, v0 = (tid & 7) * 16;
      if (t < c) { float acc[16];
#pragma unroll
        for (int i = 0; i < 16; ++i) acc[i] = 0.f;
        for (int s = 0; s <= t; ++s) { const float a = sA[t * 64 + s];
#pragma unroll
            for (int i = 0; i < 16; ++i) acc[i] += a * sV[s * 128 + v0 + i]; }
        for (int kk = 0; kk < 64; ++kk) { const float qv = sQ[t * 64 + kk];
#pragma unroll
            for (int i = 0; i < 16; ++i) acc[i] += qv * sS[kk * 128 + v0 + i]; }
        float ss = 0.f;
#pragma unroll
        for (int i = 0; i < 16; ++i) ss += acc[i] * acc[i];
        ss += __shfl_xor(ss, 1); ss += __shfl_xor(ss, 2); ss += __shfl_xor(ss, 4);
        const float rn = 1.0f / sqrtf(ss * (1.0f / 128.0f) + EPS);
        const int row = R0 + t; const float* gg = INP(I_GGLA) + l * 128 + v0; const bf16* rb = WSP(bf16, WS_RB) + (size_t)row * 512 + h * 128 + v0;
        unsigned w[8];
#pragma unroll
        for (int i = 0; i < 16; i += 2) { const float r0 = bf2f(rb[i]), r1 = bf2f(rb[i + 1]);
            const float y0 = acc[i] * rn * gg[i] * (r0 / (1.0f + __expf(-r0))), y1 = acc[i + 1] * rn * gg[i + 1] * (r1 / (1.0f + __expf(-r1)));
            w[i >> 1] = pk2(y0, y1); }
        GAS v4u* mp = (GAS v4u*)(WSP(bf16, WS_MIX) + (size_t)row * 1024 + 512 + h * 128 + v0);
        mp[0] = (v4u){w[0], w[1], w[2], w[3]}; mp[1] = (v4u){w[4], w[5], w[6], w[7]}; } }
    __syncthreads();
}

__device__ __forceinline__ void row_pass(const Args& args, unsigned char* ws, LAS unsigned char* lds, int l, int second, int vcu, int G, int wave, int lane) {
    const int gw = vcu * NWAVES + wave, NGW = G * NWAVES;
    const float* g = INP(second ? I_GFPOST : I_GMPOST) + l * 1024;
    const bool from_input = (l == 0 && !second), final = (l == NLAYER - 1 && second);
    f32x4 gv[4];
#pragma unroll
    for (int j = 0; j < 4; ++j) gv[j] = ((const GAS f32x4*)g)[lane + 64 * j];
    for (int row = gw; row < MT; row += NGW) {
        const float* xr = from_input ? (row < MP ? INP(I_XP) + (size_t)row * 1024 : INP(I_XS) + (size_t)(row - MP) * 1024) : WSP(float, WS_XRES) + (size_t)row * 1024;
        const GAS f32x4* x4 = (const GAS f32x4*)xr + lane; const GAS f32x4* m4 = (const GAS f32x4*)(WSP(float, WS_MBUF) + (size_t)row * 1024) + lane;
        f32x4 xv[4], mv[4]; float ss = 0.f;
#pragma unroll
        for (int j = 0; j < 4; ++j) { xv[j] = x4[64 * j]; mv[j] = m4[64 * j]; ss += (mv[j].x * mv[j].x + mv[j].y * mv[j].y) + (mv[j].z * mv[j].z + mv[j].w * mv[j].w); }
        ss = wave_sum(ss);
        const float rm = 1.0f / sqrtf(ss * (1.0f / 1024.0f) + EPS);
        float s2 = 0.f;
#pragma unroll
        for (int j = 0; j < 4; ++j) { xv[j] = xv[j] + mv[j] * rm * gv[j]; s2 += (xv[j].x * xv[j].x + xv[j].y * xv[j].y) + (xv[j].z * xv[j].z + xv[j].w * xv[j].w); }
        if (final) { float* orow = row < MP ? args.out + O_YP + (size_t)row * 1024 : args.out + O_YS + (size_t)(row - MP) * 1024;
#pragma unroll
            for (int j = 0; j < 4; ++j) ((GAS f32x4*)orow)[lane + 64 * j] = xv[j]; }
        else { s2 = wave_sum(s2);
            if (lane == 0) WSP(float, WS_RINV)[row] = 1.0f / sqrtf(s2 * (1.0f / 1024.0f) + EPS);
            GAS f32x4* xo = (GAS f32x4*)(WSP(float, WS_XRES) + (size_t)row * 1024) + lane; GAS unsigned long long* o8 = (GAS unsigned long long*)(WSP(bf16, WS_XB) + (size_t)row * 1024) + lane;
#pragma unroll
            for (int j = 0; j < 4; ++j) { xo[64 * j] = xv[j]; o8[64 * j] = (unsigned long long)pk2(xv[j].x, xv[j].y) | ((unsigned long long)pk2(xv[j].z, xv[j].w) << 32); } }
    }
}

__device__ __forceinline__ float gelu_tanh(float x) { const float z = 0.7978845608028654f * (x + 0.044715f * x * x * x); const float e = __expf(2.0f * z); const float th = 1.0f - 2.0f / (e + 1.0f); return 0.5f * x * (1.0f + th); }
__device__ __forceinline__ void load8_u(float (&d)[8], const bf16* U, int row, int col) { const v4u w = *(const GAS v4u*)(U + (size_t)row * DFF2 + col); UNPK8(d, 0, w); }
__device__ __forceinline__ void load8_f(float (&d)[8], const float* p) { const f32x4 a = ((const GAS f32x4*)p)[0], b = ((const GAS f32x4*)p)[1]; d[0] = a.x; d[1] = a.y; d[2] = a.z; d[3] = a.w; d[4] = b.x; d[5] = b.y; d[6] = b.z; d[7] = b.w; }
__device__ __forceinline__ void conv_geglu(const Args& args, unsigned char* ws, LAS unsigned char* lds, int l, int vcu, int G, int tid) {
    const int gt = vcu * (NWAVES * 64) + tid, NGT = G * NWAVES * 64;
    const bf16* U = WSP(bf16, WS_U); const float* cw = INP(I_CW) + (size_t)l * 3 * DFF2; const float* cb = INP(I_CB) + (size_t)l * DFF2;
    for (int it = gt; it < MT * 352; it += NGT) { const int row = it / 352, c8 = (it - row * 352) * 8;
        int t; const float* st = nullptr;
        if (row < MP) t = row & 4095; else { t = (row - MP) & 3; st = INP(I_SC) + ((size_t)l * 32 + ((row - MP) >> 2)) * 2 * DFF2; }
        float res[2][8];
#pragma unroll
        for (int half = 0; half < 2; ++half) { const int col = half * DFF + c8;
            float u2[8], u1[8], u0[8], w0[8], w1[8], w2[8], b[8];
            load8_u(u2, U, row, col);
            if (t >= 1) load8_u(u1, U, row - 1, col); else if (st) load8_f(u1, st + DFF2 + col); else {
#pragma unroll
                for (int i = 0; i < 8; ++i) u1[i] = 0.f; }
            if (t >= 2) load8_u(u0, U, row - 2, col); else if (st) load8_f(u0, st + (size_t)t * DFF2 + col); else {
#pragma unroll
                for (int i = 0; i < 8; ++i) u0[i] = 0.f; }
            load8_f(w0, cw + col); load8_f(w1, cw + DFF2 + col); load8_f(w2, cw + 2 * DFF2 + col); load8_f(b, cb + col);
#pragma unroll
            for (int i = 0; i < 8; ++i) res[half][i] = b[i] + w0[i] * u0[i] + w1[i] * u1[i] + w2[i] * u2[i]; }
        unsigned w[4];
#pragma unroll
        for (int i = 0; i < 8; i += 2) w[i >> 1] = pk2(gelu_tanh(res[0][i]) * res[1][i], gelu_tanh(res[0][i + 1]) * res[1][i + 1]);
        *(GAS v4u*)(WSP(bf16, WS_Y) + (size_t)row * DFF + c8) = (v4u){w[0], w[1], w[2], w[3]}; }
}

#ifndef MK_N_LAUNCHES
#define MK_N_LAUNCHES 1
#endif
constexpr int N_PHASES = 1 + 10 * NLAYER;
__global__ void __launch_bounds__(NWAVES * 64, 2) mk_fwd(Args args) {
    extern __shared__ __attribute__((aligned(16))) unsigned char lds_raw[];
    LAS unsigned char* lds = (LAS unsigned char*)lds_raw;
    volatile LAS unsigned* MISC = (volatile LAS unsigned*)(lds + MISC_OFF);
    const int tid0 = threadIdx.x;
    const int G = gridDim.x;
    unsigned char* ws0 = args.ws;
    for (int u = tid0; u < (LDS_BYTES - LDSCTL_OFF) / 4; u += NWAVES * 64) ((LAS unsigned*)(lds + LDSCTL_OFF))[u] = 0u;
    __syncthreads();
    if (tid0 == 0) { LAS unsigned long long* pt = (LAS unsigned long long*)(lds + PTAB_OFF);
#pragma unroll
        for (int k = 0; k < 19; ++k) pt[k] = (unsigned long long)args.in[k];
#pragma unroll
        for (int k = 0; k < 8; ++k) ((LAS float*)(lds + PTAB_OFF + 256))[k] = args.inv_freq[k]; }
    __syncthreads();
    const int lo = args.ph_lo, hi = args.ph_hi;
    XcdBarrier bar; bar.bar = (unsigned*)(ws0 + WS_CTL) + CW_BAR + args.li * XCD_BAR_WORDS; bar.x = 0; bar.st = nullptr;
    if (hi - lo > 1) bar = xcd_barrier_post((unsigned*)(ws0 + WS_CTL) + CW_BAR + args.li * XCD_BAR_WORDS, MISC + 8);

    for (int ph = lo; ph < hi; ++ph) {
        int tid = threadIdx.x; asm volatile("" : "+v"(tid));
        unsigned char* ws = ws0; asm volatile("" : "+s"(ws));
        int bx = blockIdx.x; asm volatile("" : "+s"(bx));
        const int lane = tid & 63, wave = __builtin_amdgcn_readfirstlane(tid >> 6);
        const int vcu = (G % 8 == 0) ? (bx % 8) * (G / 8) + bx / 8 : bx;
        if (ph == 0) { phase_prologue(args, ws, lds, vcu, G, wave, lane, tid); }
        else {
            const int l = (ph - 1) / 10, s = (ph - 1) % 10;
            if (s == 0) {
                pg8::Gemm g{WSP(pg8::bf16_t, WS_XB), WSP(pg8::bf16_t, WS_WIN) + (size_t)l * NIN * 1024, MPAD, NIN, 1024}; pg8::StaticOrder S; S.init(MPAD, NIN, G, bx);
                pg8::EpiProj E{ws, args.out, l};
                pg8::gemm_phase<pg8::EpiProj, pg8::StaticOrder, PG8_ALIGN, PG8_SP2>(lds + RING_OFF, g, S, E);
            } else if (s == 1) {
                LAS float* pbuf = (LAS float*)(lds + wave * 2048);
                const int gw = vcu * NWAVES + wave, NGW = G * NWAVES;
                for (int it = gw; it < MS * 8; it += NGW) attn_item_sample(ws, INP(I_CK), INP(I_CV), l, MP + (it >> 3), it & 7, pbuf, lane);
                __syncthreads();
                for (int u = vcu; u < 32 * 48; u += G) attn_unit_prompt(ws, lds, u, tid);
                __syncthreads();
                for (int u = vcu; u < GLA_UNITS; u += G) gla_local_unit(args, ws, lds, l, u, tid);
            } else if (s == 2) { gla_scan(args, ws, lds, l, vcu, G, tid); att_combine(ws, vcu, G, tid); }
            else if (s == 3) { for (int u = vcu; u < GLA_UNITS; u += G) gla_out_unit(args, ws, lds, l, u, tid); }
            else if (s == 4 || s == 8) {
                pg8::Gemm g; if (s == 4) g = pg8::Gemm{WSP(pg8::bf16_t, WS_MIX), WSP(pg8::bf16_t, WS_WOUT) + (size_t)l * 1024 * 1024, MPAD, 1024, 1024};
                             else g = pg8::Gemm{WSP(pg8::bf16_t, WS_Y), WSP(pg8::bf16_t, WS_WDN) + (size_t)l * 1024 * DFF, MPAD, 1024, DFF};
                pg8::StaticOrder S; S.init(MPAD, 1024, G, bx);
                pg8::EpiF32 E{WSP(float, WS_MBUF), 1024};
                pg8::gemm_phase<pg8::EpiF32, pg8::StaticOrder, PG8_ALIGN, PG8_SP2>(lds + RING_OFF, g, S, E);
            } else if (s == 5 || s == 9) { row_pass(args, ws, lds, l, s == 9 ? 1 : 0, vcu, G, wave, lane); }
            else if (s == 6) {
                pg8::Gemm g{WSP(pg8::bf16_t, WS_XB), WSP(pg8::bf16_t, WS_WUP) + (size_t)l * DFF2 * 1024, MPAD, DFF2, 1024}; pg8::StaticOrder S; S.init(MPAD, DFF2, G, bx);
                pg8::EpiUp E{ws, args.out, l};
                pg8::gemm_phase<pg8::EpiUp, pg8::StaticOrder, PG8_ALIGN, PG8_SP2>(lds + RING_OFF, g, S, E);
            } else if (s == 7) { conv_geglu(args, ws, lds, l, vcu, G, tid); }
        }
        if (ph + 1 < hi) xcd_barrier(bar);
    }
}

extern "C" void kernel_launch(void* const* d_in, const int* in_sizes, int n_in, void* d_out, int out_size, void* d_ws, size_t ws_size, hipStream_t stream) {
    static int grid = 0;
    if (grid == 0) {
        if (n_in != 19 || out_size != (int)O_END || ws_size < WS_END) { fprintf(stderr, "kernel_launch: unexpected shapes: n_in %d out %d ws %zu; nothing launched\n", n_in, out_size, ws_size); grid = -1; return; }
        int dev = 0, cus = 0, per_cu = 0;
        if (hipGetDevice(&dev) != hipSuccess || hipDeviceGetAttribute(&cus, hipDeviceAttributeMultiprocessorCount, dev) != hipSuccess) { fprintf(stderr, "kernel_launch: device query failed\n"); grid = -1; return; }
        if (hipFuncSetAttribute((const void*)mk_fwd, hipFuncAttributeMaxDynamicSharedMemorySize, LDS_BYTES) != hipSuccess) { fprintf(stderr, "kernel_launch: hipFuncSetAttribute failed\n"); grid = -1; return; }
        if (hipOccupancyMaxActiveBlocksPerMultiprocessor(&per_cu, (const void*)mk_fwd, NWAVES * 64, LDS_BYTES) != hipSuccess || per_cu < 1) { fprintf(stderr, "kernel_launch: occupancy query reports %d blocks per CU\n", per_cu); }
        (void)hipGetLastError();
        grid = cus;
    }
    if (grid < 0) return;
    if (hipMemsetAsync((char*)d_ws + WS_CTL, 0, CTL_ZERO_BYTES, stream) != hipSuccess) { fprintf(stderr, "kernel_launch: memset failed\n"); return; }
    Args a{};
    for (int i = 0; i < 19; ++i) a.in[i] = (const float*)d_in[i];
    a.out = (float*)d_out; a.ws = (unsigned char*)d_ws;
    for (int d = 0; d < 8; ++d) a.inv_freq[d] = (float)pow(500000.0, -(double)d / 8.0);
#if MK_N_LAUNCHES == 1
    a.ph_lo = 0; a.ph_hi = N_PHASES; a.li = 0;
    hipLaunchKernelGGL(mk_fwd, dim3(grid), dim3(NWAVES * 64), LDS_BYTES, stream, a);
#else
    for (int ph = 0; ph < N_PHASES; ++ph) { a.ph_lo = ph; a.ph_hi = ph + 1; a.li = 0; hipLaunchKernelGGL(mk_fwd, dim3(grid), dim3(NWAVES * 64), LDS_BYTES, stream, a); }
#endif
    const hipError_t le = hipPeekAtLastError();
    if (le != hipSuccess) fprintf(stderr, "kernel_launch: launch failed: %s\n", hipGetErrorName(le));
}
```
